# Optimizing an MI355X kernel written in HIP

```python
import numpy as np
import jax
import jax.numpy as jnp
from jax import lax

D_MODEL = 1024
BATCH = 16
SEQ = 2048
DEPTH = 4

GRID_W = 64
CTX_LEN = 256
HEAD_DIM = 64
MIX_WIDTH = D_MODEL
ATT_WIDTH = MIX_WIDTH // 2
RET_WIDTH = MIX_WIDTH // 4
FOURIER_WIDTH = MIX_WIDTH - ATT_WIDTH - RET_WIDTH
ATT_Q_HEADS = ATT_WIDTH // HEAD_DIM
ATT_KV_HEADS = ATT_Q_HEADS // 4
ATT_GROUP = ATT_Q_HEADS // ATT_KV_HEADS
KV_WIDTH = ATT_KV_HEADS * HEAD_DIM
WINDOW = 128
BLOCK = 128
RET_HEADS = RET_WIDTH // HEAD_DIM
RET_CHUNK = 128
FOURIER_GROUPS = 4
FOURIER_DIM = FOURIER_WIDTH // FOURIER_GROUPS
PROJ_SIZES = (ATT_WIDTH, KV_WIDTH, KV_WIDTH, RET_WIDTH, RET_WIDTH, RET_WIDTH, RET_WIDTH, RET_WIDTH, FOURIER_WIDTH)
PROJ_WIDTH = ATT_WIDTH + 2 * KV_WIDTH + 5 * RET_WIDTH + FOURIER_WIDTH
D_FF = 4 * D_MODEL
N_MOD = 6
ROPE_BASE = 10000.0
EPS = 1e-6
NEG_INF = -1e30

kernel_name = 'hybrid_parallel_heads_dit_block'


def rms_norm(x, g):
    xf = x.astype(jnp.float32)
    y = xf * lax.rsqrt(jnp.mean(xf * xf, axis=-1, keepdims=True) + EPS)
    return (y * g.astype(jnp.float32)).astype(x.dtype)


def modulate(x, g, shift, scale):
    return rms_norm(x, g) * (1 + scale) + shift


def rope_table(pos, dim):
    half = dim // 2
    freqs = ROPE_BASE ** (-jnp.arange(half, dtype=jnp.float32) / half)
    ang = pos.astype(jnp.float32)[:, None] * freqs[None, :]
    return jnp.cos(ang)[:, None, :], jnp.sin(ang)[:, None, :]


def rope_rotate(x, cos, sin):
    cos = cos.astype(x.dtype)
    sin = sin.astype(x.dtype)
    x1, x2 = jnp.split(x, 2, axis=-1)
    return jnp.concatenate([x1 * cos - x2 * sin, x2 * cos + x1 * sin], axis=-1)


def axial_rope(x, row_tab, col_tab):
    xr, xc = jnp.split(x, 2, axis=-1)
    return jnp.concatenate([rope_rotate(xr, *row_tab), rope_rotate(xc, *col_tab)], axis=-1)


def split_heads(t, n_heads):
    return t.reshape(t.shape[0], t.shape[1], n_heads, -1)


def split_proj(p):
    offsets = np.cumsum(PROJ_SIZES)[:-1].tolist()
    return jnp.split(p, offsets, axis=-1)


def window_attention_latent(q, k, v, k_ctx, v_ctx, sink):
    b, s, _, d = q.shape
    nb = s // BLOCK
    lc = k_ctx.shape[1]
    qb = q.reshape(b, nb, BLOCK, ATT_KV_HEADS, ATT_GROUP, d)

    def band(t):
        tp = jnp.pad(t, ((0, 0), (BLOCK, BLOCK), (0, 0), (0, 0))).reshape(b, nb + 2, BLOCK, ATT_KV_HEADS, d)
        return jnp.concatenate([tp[:, :-2], tp[:, 1:-1], tp[:, 2:]], axis=2)

    kb, vb = band(k), band(v)
    scale = d ** -0.5
    s_band = jnp.einsum('bnqhgd,bnkhd->bnhgqk', qb, kb).astype(jnp.float32) * scale
    s_ctx = jnp.einsum('bnqhgd,bkhd->bnhgqk', qb, k_ctx).astype(jnp.float32) * scale
    qi = jnp.arange(BLOCK)
    kj = jnp.arange(3 * BLOCK)
    kpos = jnp.arange(nb)[:, None] * BLOCK - BLOCK + kj[None, :]
    in_window = jnp.abs(kj[None, :] - BLOCK - qi[:, None]) <= WINDOW
    valid = in_window[None] & ((kpos >= 0) & (kpos < s))[:, None, :]
    s_band = jnp.where(valid[None, :, None, None], s_band, NEG_INF)
    s_sink = jnp.broadcast_to(
        sink.astype(jnp.float32).reshape(1, 1, ATT_KV_HEADS, ATT_GROUP, 1, 1), s_band.shape[:-1] + (1,))
    p = jax.nn.softmax(jnp.concatenate([s_band, s_ctx, s_sink], axis=-1), axis=-1)
    p_band = p[..., :3 * BLOCK].astype(v.dtype)
    p_ctx = p[..., 3 * BLOCK:3 * BLOCK + lc].astype(v.dtype)
    o = (jnp.einsum('bnhgqk,bnkhd->bnqhgd', p_band, vb)
         + jnp.einsum('bnhgqk,bkhd->bnqhgd', p_ctx, v_ctx))
    return o.reshape(b, s, ATT_Q_HEADS * d)


def context_attention(q, k, v, sink):
    b, l, _, d = q.shape
    qg = q.reshape(b, l, ATT_KV_HEADS, ATT_GROUP, d)
    s = jnp.einsum('bqhgd,bkhd->bhgqk', qg, k).astype(jnp.float32) * d ** -0.5
    s_sink = jnp.broadcast_to(
        sink.astype(jnp.float32).reshape(1, ATT_KV_HEADS, ATT_GROUP, 1, 1), s.shape[:-1] + (1,))
    p = jax.nn.softmax(jnp.concatenate([s, s_sink], axis=-1), axis=-1)
    o = jnp.einsum('bhgqk,bkhd->bqhgd', p[..., :l].astype(v.dtype), v)
    return o.reshape(b, l, ATT_Q_HEADS * d)


def retention_scan(q, k, v, log_gamma, state0):
    b, l, h, _ = q.shape
    n = l // RET_CHUNK
    idx = jnp.arange(RET_CHUNK, dtype=jnp.float32)
    diff = idx[:, None] - idx[None, :]
    inner_decay = jnp.where(diff[None] >= 0,
                            jnp.exp(jnp.maximum(diff, 0.0)[None] * log_gamma[:, None, None]), 0.0)
    xi = jnp.exp((idx[:, None] + 1.0) * log_gamma[None, :])
    zeta = jnp.exp((RET_CHUNK - 1.0 - idx)[:, None] * log_gamma[None, :])
    chunk_decay = jnp.exp(RET_CHUNK * log_gamma)

    def to_chunks(t):
        return t.reshape(b, n, RET_CHUNK, h, t.shape[-1]).swapaxes(0, 1)

    def step(state, inp):
        qc, kc, vc = inp
        sc = jnp.einsum('bihd,bjhd->bhij', qc, kc) * inner_decay[None]
        inner = jnp.einsum('bhij,bjhe->bihe', sc, vc)
        cross = jnp.einsum('bihd,bhde->bihe', qc, state) * xi[None, :, :, None]
        new_state = (state * chunk_decay[None, :, None, None]
                     + jnp.einsum('bjhd,bjhe->bhde', kc * zeta[None, :, :, None], vc))
        return new_state, inner + cross

    final, out = lax.scan(step, state0, (to_chunks(q), to_chunks(k), to_chunks(v)))
    return out.swapaxes(0, 1).reshape(b, l, h, v.shape[-1]), final


def head_group_norm(o, g):
    mu = jnp.mean(o, axis=-1, keepdims=True)
    var = jnp.mean(jnp.square(o - mu), axis=-1, keepdims=True)
    y = (o - mu) * lax.rsqrt(var + EPS)
    return y.reshape(o.shape[0], o.shape[1], -1) * g.astype(jnp.float32)


def fourier_mix(u, w):
    b, l, _ = u.shape
    uf = u.astype(jnp.float32).reshape(b, l, FOURIER_GROUPS, FOURIER_DIM)
    y = jnp.fft.fft2(uf, axes=(1, 3), norm='ortho').real
    return jnp.einsum('blgc,gcd->blgd', y, w.astype(jnp.float32)).reshape(b, l, FOURIER_WIDTH).astype(u.dtype)


def sq_relu_mlp(h, w1, w2):
    return jnp.square(jax.nn.relu(h @ w1)) @ w2


def token_mixers(a_lat, a_ctx, w_in, w_out, q_g, k_g, sink, decay_logit, gn_g, four_w,
                 row_tab, col_tab, t_tab, need_ctx):
    aq, ak, av, rq, rk, rv, rgf, rgb, fu = split_proj(a_lat @ w_in)
    cq, ck, cv, crq, crk, crv, crgf, crgb, cfu = split_proj(a_ctx @ w_in)

    q = axial_rope(rms_norm(split_heads(aq, ATT_Q_HEADS), q_g), row_tab, col_tab)
    k = axial_rope(rms_norm(split_heads(ak, ATT_KV_HEADS), k_g), row_tab, col_tab)
    v = split_heads(av, ATT_KV_HEADS)
    kc = rms_norm(split_heads(ck, ATT_KV_HEADS), k_g)
    vc = split_heads(cv, ATT_KV_HEADS)
    att_lat = window_attention_latent(q, k, v, kc, vc, sink)

    log_gamma = -jax.nn.softplus(-decay_logit.astype(jnp.float32))

    def ret_qkv(tq, tk, tv):
        return (split_heads(tq, RET_HEADS).astype(jnp.float32),
                split_heads(tk, RET_HEADS).astype(jnp.float32) * HEAD_DIM ** -0.5,
                split_heads(tv, RET_HEADS).astype(jnp.float32))

    lq, lk, lv = ret_qkv(rq, rk, rv)
    lq = rope_rotate(lq, *t_tab)
    lk = rope_rotate(lk, *t_tab)
    xq, xk, xv = ret_qkv(crq, crk, crv)
    zero = jnp.zeros((a_lat.shape[0], RET_HEADS, HEAD_DIM, HEAD_DIM), jnp.float32)

    def flip(t):
        return jnp.flip(t, axis=1)

    oc_f, st_f = retention_scan(xq, xk, xv, log_gamma[0], zero)
    oc_b, st_b = retention_scan(flip(xq), flip(xk), flip(xv), log_gamma[1], zero)
    ol_f, _ = retention_scan(lq, lk, lv, log_gamma[0], st_f)
    ol_b, _ = retention_scan(flip(lq), flip(lk), flip(lv), log_gamma[1], st_b)

    def ret_out(o_f, o_b, gf, gb):
        y = (head_group_norm(o_f, gn_g) * jax.nn.silu(gf.astype(jnp.float32))
             + head_group_norm(o_b, gn_g) * jax.nn.silu(gb.astype(jnp.float32)))
        return y.astype(gf.dtype)

    ret_lat = ret_out(ol_f, flip(ol_b), rgf, rgb)

    four_lat = fourier_mix(fu, four_w)

    m_lat = jnp.concatenate([att_lat, ret_lat, four_lat], axis=-1) @ w_out
    if not need_ctx:
        return m_lat, None

    qc = rms_norm(split_heads(cq, ATT_Q_HEADS), q_g)
    att_ctx = context_attention(qc, kc, vc, sink)
    ret_ctx = ret_out(oc_f, flip(oc_b), crgf, crgb)
    four_ctx = fourier_mix(cfu, four_w)
    m_ctx = jnp.concatenate([att_ctx, ret_ctx, four_ctx], axis=-1) @ w_out
    return m_lat, m_ctx


def setup_inputs(seed: int = 0) -> dict:
    key = jax.random.key(seed)
    ks = jax.random.split(key, 20)
    f32 = jnp.float32

    def nrm(k, shape, scale):
        return jax.random.normal(k, shape, f32) * scale

    base_logit = jnp.asarray(np.log(2.0 ** (5 + np.arange(RET_HEADS)) - 1.0), f32)
    return {
        'x': nrm(ks[0], (BATCH, SEQ, D_MODEL), 1.0),
        'c': nrm(ks[1], (BATCH, D_MODEL), 1.0),
        'ctx': nrm(ks[2], (BATCH, CTX_LEN, D_MODEL), 1.0),
        'c_ctx': nrm(ks[3], (D_MODEL,), 1.0),
        'w_mod': nrm(ks[4], (DEPTH, D_MODEL, N_MOD * D_MODEL), 0.5 * D_MODEL ** -0.5),
        'b_mod': nrm(ks[5], (DEPTH, N_MOD * D_MODEL), 0.01),
        'norm1_g': 1.0 + nrm(ks[6], (DEPTH, D_MODEL), 0.01),
        'norm2_g': 1.0 + nrm(ks[7], (DEPTH, D_MODEL), 0.01),
        'w_in': nrm(ks[8], (DEPTH, D_MODEL, PROJ_WIDTH), D_MODEL ** -0.5),
        'w_out': nrm(ks[9], (DEPTH, MIX_WIDTH, D_MODEL), MIX_WIDTH ** -0.5),
        'q_norm_g': 1.0 + nrm(ks[10], (DEPTH, HEAD_DIM), 0.01),
        'k_norm_g': 1.0 + nrm(ks[11], (DEPTH, HEAD_DIM), 0.01),
        'attn_sink': nrm(ks[12], (DEPTH, ATT_Q_HEADS), 0.5),
        'ret_decay_logit': base_logit[None, None, :] + nrm(ks[13], (DEPTH, 2, RET_HEADS), 0.1),
        'ret_gn_g': 1.0 + nrm(ks[14], (DEPTH, RET_WIDTH), 0.01),
        'fourier_w': nrm(ks[15], (DEPTH, FOURIER_GROUPS, FOURIER_DIM, FOURIER_DIM), FOURIER_DIM ** -0.5),
        'w_ff1': nrm(ks[16], (DEPTH, D_MODEL, D_FF), D_MODEL ** -0.5),
        'w_ff2': nrm(ks[17], (DEPTH, D_FF, D_MODEL), D_FF ** -0.5),
    }


def reference(x, c, ctx, c_ctx, w_mod, b_mod, norm1_g, norm2_g, w_in, w_out, q_norm_g, k_norm_g,
              attn_sink, ret_decay_logit, ret_gn_g, fourier_w, w_ff1, w_ff2):
    s = x.shape[1]
    rows = s // GRID_W
    rr, cc = jnp.meshgrid(jnp.arange(rows), jnp.arange(GRID_W), indexing='ij')
    row_tab = rope_table(rr.reshape(-1), HEAD_DIM // 2)
    col_tab = rope_table(cc.reshape(-1), HEAD_DIM // 2)
    t_tab = rope_table(jnp.arange(s), HEAD_DIM)
    silu_c = jax.nn.silu(c)
    silu_cc = jax.nn.silu(c_ctx)
    h = ctx
    for l in range(DEPTH):
        need_ctx = l < DEPTH - 1
        mod_lat = jnp.split((silu_c @ w_mod[l] + b_mod[l])[:, None, :], N_MOD, axis=-1)
        mod_ctx = jnp.split((silu_cc @ w_mod[l] + b_mod[l])[None, None, :], N_MOD, axis=-1)
        a_lat = modulate(x, norm1_g[l], mod_lat[0], mod_lat[1])
        a_ctx = modulate(h, norm1_g[l], mod_ctx[0], mod_ctx[1])
        m_lat, m_ctx = token_mixers(a_lat, a_ctx, w_in[l], w_out[l], q_norm_g[l], k_norm_g[l], attn_sink[l],
                                    ret_decay_logit[l], ret_gn_g[l], fourier_w[l],
                                    row_tab, col_tab, t_tab, need_ctx)
        x = x + mod_lat[2] * m_lat
        x = x + mod_lat[5] * sq_relu_mlp(modulate(x, norm2_g[l], mod_lat[3], mod_lat[4]), w_ff1[l], w_ff2[l])
        if need_ctx:
            h = h + mod_ctx[2] * m_ctx
            h = h + mod_ctx[5] * sq_relu_mlp(modulate(h, norm2_g[l], mod_ctx[3], mod_ctx[4]), w_ff1[l], w_ff2[l])
    return x
```

```cpp
#include <hip/hip_runtime.h>
#include <hip/hip_cooperative_groups.h>
#include <cstdio>
#include <cstdint>
namespace cg = cooperative_groups;
#ifndef ONE_LAUNCH
#define ONE_LAUNCH 1
#endif
namespace pg8 {
#define PG8_LAS __attribute__((address_space(3)))
typedef unsigned short bf16_t;
typedef short bf16x8 __attribute__((ext_vector_type(8)));
typedef float f32x4 __attribute__((ext_vector_type(4)));
typedef unsigned u32x4 __attribute__((ext_vector_type(4)));
constexpr int BM = 256, BK = 64, HALF = 128, HTB = HALF * BK * 2  , STAGE_BYTES = 8 * HTB, NXCD = 8, WGM = 8;

__host__ __device__ __forceinline__ int lds_byte(int r, int c) { const int st = (r >> 4) * 2 + (c >> 5), rr = r & 15, cc = c & 31, ob = rr * 64 + cc * 2; return st * 1024 + (ob ^ (((ob >> 9) & 1) << 5)); }
__host__ __device__ __forceinline__ void stage_rc(int b, int& R, int& C) { const int st = b / 1024, sb = b % 1024, swz = sb ^ (((sb >> 9) & 1) << 5); R = (st >> 1) * 16 + swz / 64; C = (st & 1) * 32 + (swz % 64) / 2; }
__host__ __device__ __forceinline__ int perm32(int rho) { const int n = rho >> 4, i = rho & 15; return 8 * (i >> 2) + 4 * n + (i & 3); }

struct Unit { int pm, pn; };
struct Gemm { const bf16_t* A; const bf16_t* Bt; int M, N, K; };

struct StaticOrder {
    int nM, nN, nwg, G, c, rev = 0;
    __host__ __device__ void init(int M, int N, int G_, int c_) { nM = M / BM; nN = N / BM; nwg = nM * nN; G = G_; c = c_; }
    __host__ __device__ bool next(int i, Unit& u) const {
        const long L = (long)i * G + c; if (L >= nwg) return false;
        int wgid = (int)L; { const int q = nwg / NXCD, r = nwg % NXCD, xcd = wgid % NXCD, off = wgid / NXCD; wgid = (xcd < r ? xcd * (q + 1) : r * (q + 1) + (xcd - r) * q) + off; }
        const int nig = WGM * nN, gid = wgid / nig, fm = gid * WGM, gsz = (nM - fm) < WGM ? (nM - fm) : WGM;
        u.pm = fm + ((wgid % nig) % gsz); u.pn = (wgid % nig) / gsz; if (rev) u.pm = nM - 1 - u.pm; return true;
    }
    __device__ __forceinline__ void a_ready(const Unit&) const {}
    __device__ __forceinline__ void done(const Unit&) const {}
};

__device__ __forceinline__ unsigned cvt_pk_bf16(float lo, float hi) { unsigned r; asm volatile("v_cvt_pk_bf16_f32 %0, %1, %2" : "=v"(r) : "v"(lo), "v"(hi)); return r; }
template <class Epi, class Sched, bool ALIGN_EPI = false, bool SP2 = false>
__device__ __forceinline__ void gemm_phase(PG8_LAS unsigned char* lds, const Gemm g, const Sched& S, const Epi& E) {
    int tid_ = threadIdx.x; asm volatile("" : "+v"(tid_));
    const int tid = tid_, wid = __builtin_amdgcn_readfirstlane(tid >> 6), lane = tid & 63, wr = wid >> 2, wc = wid & 3, fr = lane & 15, fq = lane >> 4;
    const int K = g.K, nt = K / BK;
    unsigned voffA[2], voffB[2];
#pragma unroll
    for (int i = 0; i < 2; ++i) { int R, C; stage_rc(tid * 16 + i * 8192, R, C); const int Rb = Epi::PERM ? ((R & ~31) + perm32(R & 31)) : R;
        voffA[i] = (unsigned)(R * K + C) * 2u; voffB[i] = (unsigned)(Rb * K + C) * 2u; }
    const size_t kstep = (size_t)(BK * 2);
    const size_t hstep = (size_t)HALF * K * 2;
    const size_t tstep = 2 * hstep;
    const unsigned ldsw = (unsigned)wid * 1024u;
    const int aoff = lds_byte(wr * 64 + fr, fq * 8), boff = lds_byte(wc * 32 + fr, fq * 8);
#define PG8_SA(b, h) (((b) * 2 + (h)) * HTB)
#define PG8_SB(b, h) ((4 + (b) * 2 + (h)) * HTB)
#define PG8_STAGE(bufoff, gbase, voff) do { _Pragma("unroll") for (int _i = 0; _i < 2; ++_i) \
        __builtin_amdgcn_global_load_lds((const unsigned*)((const char*)(gbase) + (voff)[_i]), (PG8_LAS unsigned*)(lds + (bufoff) + ldsw + _i * 8192), 16, 0, 0); } while (0)
#define PG8_LDA(dst, b, h) do { _Pragma("unroll") for (int m = 0; m < 4; ++m) _Pragma("unroll") for (int k = 0; k < 2; ++k) dst[m][k] = *(const PG8_LAS bf16x8*)(lds + PG8_SA(b, h) + aoff + m * 2048 + k * 1024); } while (0)
#define PG8_LDB(dst, b, h) do { _Pragma("unroll") for (int n = 0; n < 2; ++n) _Pragma("unroll") for (int k = 0; k < 2; ++k) dst[n][k] = *(const PG8_LAS bf16x8*)(lds + PG8_SB(b, h) + boff + n * 2048 + k * 1024); } while (0)
#define PG8_MMA(ai, bj, At, Bt) do { __builtin_amdgcn_s_setprio(1); _Pragma("unroll") for (int m = 0; m < 4; ++m) _Pragma("unroll") for (int n = 0; n < 2; ++n) _Pragma("unroll") for (int k = 0; k < 2; ++k) \
        acc[ai][bj][m][n] = __builtin_amdgcn_mfma_f32_16x16x32_bf16(Bt[n][k], At[m][k], acc[ai][bj][m][n], 0, 0, 0); __builtin_amdgcn_s_setprio(0); } while (0)
#define PG8_WAIT_V(n) asm volatile("s_waitcnt vmcnt(" #n ")" ::: "memory")
#define PG8_WAIT_L(n) asm volatile("s_waitcnt lgkmcnt(" #n ")" ::: "memory")
#define PG8_BAR __builtin_amdgcn_s_barrier()
#define PG8_SCHED __builtin_amdgcn_sched_barrier(0)
    Unit cur, nxt; int ui = 0;
    if (!S.next(0, cur)) return;
    f32x4 acc[2][2][4][2];
#pragma unroll
    for (int a = 0; a < 2; ++a)
#pragma unroll
        for (int b = 0; b < 2; ++b)
#pragma unroll
            for (int m = 0; m < 4; ++m)
#pragma unroll
                for (int n = 0; n < 2; ++n) acc[a][b][m][n] = (f32x4){0.f, 0.f, 0.f, 0.f};
    bf16x8 At[4][2], B0[2][2], B1[2][2];
    const char* cA = (const char*)g.A + (size_t)cur.pm * tstep; const char* cB = (const char*)g.Bt + (size_t)cur.pn * tstep;
    S.a_ready(cur);
    if constexpr (SP2) {
        PG8_STAGE(PG8_SB(0, 0), cB, voffB); PG8_STAGE(PG8_SB(0, 1), cB + hstep, voffB); PG8_STAGE(PG8_SA(0, 0), cA, voffA); PG8_STAGE(PG8_SA(0, 1), cA + hstep, voffA);
        if (wr == 1) PG8_BAR;
        PG8_WAIT_V(2); PG8_BAR;
        PG8_STAGE(PG8_SB(1, 0), cB + kstep, voffB); PG8_STAGE(PG8_SA(1, 0), cA + kstep, voffA); PG8_STAGE(PG8_SB(1, 1), cB + hstep + kstep, voffB);
        PG8_WAIT_V(6); PG8_BAR;
    } else {
        PG8_STAGE(PG8_SB(0, 0), cB, voffB); PG8_STAGE(PG8_SA(0, 0), cA, voffA); PG8_STAGE(PG8_SB(0, 1), cB + hstep, voffB); PG8_STAGE(PG8_SA(0, 1), cA + hstep, voffA);
        if (wr == 1) PG8_BAR;
        PG8_WAIT_V(4); PG8_BAR;
        PG8_STAGE(PG8_SB(1, 0), cB + kstep, voffB); PG8_STAGE(PG8_SA(1, 0), cA + kstep, voffA); PG8_STAGE(PG8_SB(1, 1), cB + hstep + kstep, voffB);
        PG8_WAIT_V(6); PG8_BAR;
    }
    for (;;) {
        const bool has_next = S.next(ui + 1, nxt);
        const char* nA = has_next ? (const char*)g.A + (size_t)nxt.pm * tstep : cA; const char* nB = has_next ? (const char*)g.Bt + (size_t)nxt.pn * tstep : cB;
        for (int t = 0; t < nt; t += 2) {
            const bool last = (t == nt - 2);
            const char* a1 = cA + (size_t)(t + 1) * kstep;
            const char* a2 = last ? nA : cA + (size_t)(t + 2) * kstep; const char* b2 = last ? nB : cB + (size_t)(t + 2) * kstep;
            const char* a3 = a2 + kstep; const char* b3 = b2 + kstep;
            if (last && has_next) S.a_ready(nxt);
            if constexpr (SP2) {
            PG8_LDB(B0, 0, 0); PG8_LDB(B1, 0, 1); PG8_SCHED; PG8_LDA(At, 0, 0); PG8_STAGE(PG8_SA(1, 1), a1 + hstep, voffA);
            PG8_WAIT_V(8); PG8_WAIT_L(0); PG8_BAR; PG8_MMA(0, 0, At, B0); PG8_MMA(0, 1, At, B1); PG8_BAR; PG8_SCHED;
            PG8_LDA(At, 0, 1); PG8_STAGE(PG8_SB(0, 0), b2, voffB); PG8_STAGE(PG8_SB(0, 1), b2 + hstep, voffB); PG8_STAGE(PG8_SA(0, 0), a2, voffA);
            PG8_WAIT_V(8); PG8_WAIT_L(0); PG8_BAR; PG8_MMA(1, 0, At, B0); PG8_MMA(1, 1, At, B1); PG8_BAR; PG8_SCHED;
            PG8_LDB(B0, 1, 0); PG8_LDB(B1, 1, 1); PG8_SCHED; PG8_LDA(At, 1, 0); PG8_STAGE(PG8_SA(0, 1), a2 + hstep, voffA);
            PG8_WAIT_V(8); PG8_WAIT_L(0); PG8_BAR; PG8_MMA(0, 0, At, B0); PG8_MMA(0, 1, At, B1); PG8_BAR; PG8_SCHED;
            PG8_LDA(At, 1, 1); PG8_STAGE(PG8_SB(1, 0), b3, voffB); PG8_STAGE(PG8_SB(1, 1), b3 + hstep, voffB); PG8_STAGE(PG8_SA(1, 0), a3, voffA);
            PG8_WAIT_V(8); PG8_WAIT_L(0); PG8_BAR; PG8_MMA(1, 0, At, B0); PG8_MMA(1, 1, At, B1); PG8_BAR; PG8_SCHED;
            } else {
            PG8_LDB(B0, 0, 0); PG8_SCHED; PG8_LDA(At, 0, 0); PG8_STAGE(PG8_SA(1, 1), a1 + hstep, voffA);
            PG8_WAIT_L(8); PG8_BAR; PG8_WAIT_L(0); PG8_MMA(0, 0, At, B0); PG8_BAR; PG8_SCHED;
            PG8_LDB(B1, 0, 1); PG8_STAGE(PG8_SB(0, 0), b2, voffB);
            PG8_BAR; PG8_WAIT_L(0); PG8_MMA(0, 1, At, B1); PG8_BAR;
            PG8_LDA(At, 0, 1); PG8_STAGE(PG8_SA(0, 0), a2, voffA);
            PG8_BAR; PG8_WAIT_L(0); PG8_MMA(1, 0, At, B0); PG8_BAR; PG8_SCHED;
            PG8_STAGE(PG8_SB(0, 1), b2 + hstep, voffB);
            PG8_WAIT_V(6); PG8_BAR; PG8_MMA(1, 1, At, B1); PG8_BAR;
            PG8_LDB(B0, 1, 0); PG8_SCHED; PG8_LDA(At, 1, 0); PG8_STAGE(PG8_SA(0, 1), a2 + hstep, voffA);
            PG8_WAIT_L(8); PG8_BAR; PG8_WAIT_L(0); PG8_MMA(0, 0, At, B0); PG8_BAR; PG8_SCHED;
            PG8_LDB(B1, 1, 1); PG8_STAGE(PG8_SB(1, 0), b3, voffB);
            PG8_BAR; PG8_WAIT_L(0); PG8_MMA(0, 1, At, B1); PG8_BAR;
            PG8_LDA(At, 1, 1); PG8_STAGE(PG8_SA(1, 0), a3, voffA);
            PG8_BAR; PG8_WAIT_L(0); PG8_MMA(1, 0, At, B0); PG8_BAR; PG8_SCHED;
            PG8_STAGE(PG8_SB(1, 1), b3 + hstep, voffB);
            PG8_WAIT_V(6); PG8_BAR; PG8_MMA(1, 1, At, B1); PG8_BAR;
            }
        }
        if constexpr (ALIGN_EPI) { if (wr == 0) PG8_BAR; }
        if constexpr (!Epi::AFTER_DRAIN) { E(acc, cur, wr, wc, fr, fq); S.done(cur); }
        if (!has_next) break;
#pragma unroll
        for (int a = 0; a < 2; ++a)
#pragma unroll
            for (int b = 0; b < 2; ++b)
#pragma unroll
                for (int m = 0; m < 4; ++m)
#pragma unroll
                    for (int n = 0; n < 2; ++n) acc[a][b][m][n] = (f32x4){0.f, 0.f, 0.f, 0.f};
        cur = nxt; cA = nA; cB = nB; ++ui;
        if constexpr (ALIGN_EPI) { if (wr == 1) PG8_BAR; }
    }
    PG8_WAIT_V(0);
    if constexpr (!ALIGN_EPI) { if (wr == 0) PG8_BAR; }
    PG8_BAR;
    if constexpr (Epi::AFTER_DRAIN) { E.fused(acc, cur, wr, wc, fr, fq, lds, wid, lane); S.done(cur); }
#undef PG8_SA
#undef PG8_SB
#undef PG8_STAGE
#undef PG8_LDA
#undef PG8_LDB
#undef PG8_MMA
#undef PG8_WAIT_V
#undef PG8_WAIT_L
#undef PG8_BAR
#undef PG8_SCHED
}
}

namespace mk {
#define LAS __attribute__((address_space(3)))
#define DI __device__ __forceinline__
#define AS4 __attribute__((address_space(4)))
typedef unsigned short bf16;
typedef short bf16x8 __attribute__((ext_vector_type(8)));
typedef short s16x4 __attribute__((ext_vector_type(4)));
typedef short v4i16_t __attribute__((ext_vector_type(4)));
typedef float f32x4 __attribute__((ext_vector_type(4)));
typedef float f32x16 __attribute__((ext_vector_type(16)));
typedef unsigned u32x2 __attribute__((ext_vector_type(2)));
typedef unsigned u32x4 __attribute__((ext_vector_type(4)));
typedef float f32x2_t __attribute__((ext_vector_type(2)));
typedef __bf16 bf16x2_t __attribute__((ext_vector_type(2)));

constexpr int D = 1024, NB = 16, SEQ = 2048, LCTX = 256, DEPTH = 4;
constexpr int NLAT = NB * SEQ, NCTX = NB * LCTX, M = NLAT + NCTX;
constexpr int PW = 2304, NIN = 2560, FF = 4096, PC = 2048;
constexpr int C_AQ = 0, C_AK = 512, C_AV = 640, C_RQ = 768, C_RK = 1024, C_RV = 1280, C_GF = 1536, C_GB = 1792;
constexpr int NCH = 18;
constexpr float LOG2E = 1.4426950408889634f;

constexpr size_t MiB = 1u << 20;
constexpr size_t WS_CTL = 0, WS_MOD = 1 * MiB, WS_AXT = 3 * MiB, WS_RT = 3 * MiB + 65536, WS_DFTC = 4 * MiB, WS_DFTL = 5 * MiB;
constexpr size_t WS_WIN = 21 * MiB, WS_WOUT = 41 * MiB, WS_W1 = 49 * MiB, WS_W2 = 81 * MiB, WS_XC = 113 * MiB, WS_A = 129 * MiB;
constexpr size_t WS_H = 201 * MiB, WS_P = 201 * MiB, WS_TTL = 345 * MiB, WS_TTC = 377 * MiB, WS_KV = 381 * MiB, WS_Y = 417 * MiB, WS_RSS = 489 * MiB, WS_BIAS = 491 * MiB, WS_GS = 493 * MiB, WS_END = 494 * MiB;
constexpr int LDS_BYTES = 147456, LDS_ITEM = 131072;

struct Args { const float* in[18]; float* out; unsigned char* ws; int lo, hi; };

DI unsigned pk2(float lo, float hi) { f32x2_t v = {lo, hi}; bf16x2_t b = __builtin_convertvector(v, bf16x2_t); return __builtin_bit_cast(unsigned, b); }
DI float bf2f(short x) { return __uint_as_float(((unsigned)(unsigned short)x) << 16); }
DI float bflo(unsigned w) { return __uint_as_float(w << 16); }
DI float bfhi(unsigned w) { return __uint_as_float(w & 0xffff0000u); }
DI float ex2(float x) { return __builtin_amdgcn_exp2f(x); }
DI int tid_opaque() { int t = threadIdx.x; asm volatile("" : "+v"(t)); return t; }
DI float wave_sum(float v) {
#pragma unroll
    for (int o = 1; o < 64; o <<= 1) v += __shfl_xor(v, o);
    return v;
}
#define LDS_WAIT() asm volatile("s_waitcnt lgkmcnt(0)" ::: "memory")
#define MFMA32(a, b, c) __builtin_amdgcn_mfma_f32_32x32x16_bf16((a), (b), (c), 0, 0, 0)
DI s16x4 tr_read(const LAS unsigned char* p) { return __builtin_bit_cast(s16x4, __builtin_amdgcn_ds_read_tr16_b64_v4i16((LAS v4i16_t*)p)); }
DI bf16x8 cat8(s16x4 lo, s16x4 hi) { return __builtin_shufflevector(lo, hi, 0, 1, 2, 3, 4, 5, 6, 7); }
DI int crow(int r, int h) { return (r & 3) + 8 * (r >> 2) + 4 * h; }
DI bf16x8 pack8(const f32x16& x, int s) {
    u32x4 p; p.x = pk2(x[8 * s], x[8 * s + 1]); p.y = pk2(x[8 * s + 2], x[8 * s + 3]); p.z = pk2(x[8 * s + 4], x[8 * s + 5]); p.w = pk2(x[8 * s + 6], x[8 * s + 7]);
    return __builtin_bit_cast(bf16x8, p);
}
DI f32x16 zero16() { f32x16 z;
#pragma unroll
    for (int i = 0; i < 16; ++i) z[i] = 0.f; return z; }

DI int prow(int n) { const int pn = n >> 8, co = n & 255; return 256 * pn + 128 * ((co >> 5) & 1) + 32 * (co >> 6) + (co & 31); }

DI void p0_transpose_item(const float* W, int ldw, int nblk, bf16* WT, int K, bool permute, LAS float* scr, int item, int lane) {
    const int kb = item / nblk, nb = item % nblk, k0 = 64 * kb, n0 = 32 * nb;
    float tv[32];
    { const float* wp = W + (size_t)(k0 + (lane >> 5)) * ldw + n0 + (lane & 31);
#pragma unroll
      for (int i = 0; i < 32; ++i) tv[i] = wp[(size_t)(2 * i) * ldw]; }
#pragma unroll
    for (int i = 0; i < 32; ++i) scr[(2 * i + (lane >> 5)) * 33 + (lane & 31)] = tv[i];
    LDS_WAIT();
    const int r0 = permute ? prow(n0) : n0;
    const int c = lane & 7;
#pragma unroll
    for (int j = 0; j < 4; ++j) { const int n = (lane >> 3) + 8 * j; const LAS float* s = scr + (8 * c) * 33 + n;
        u32x4 o; o.x = pk2(s[0 * 33], s[1 * 33]); o.y = pk2(s[2 * 33], s[3 * 33]); o.z = pk2(s[4 * 33], s[5 * 33]); o.w = pk2(s[6 * 33], s[7 * 33]);
        *(u32x4*)(WT + (size_t)(r0 + n) * K + k0 + 8 * c) = o; }
    LDS_WAIT();
}

DI void p0_weights(const Args& a, LAS unsigned char* lds, int l0, int l1, int wblk, int nblk) {
    const int tid = tid_opaque(), lane = tid & 63, wave = tid >> 6;
    const int gw = wblk * 8 + wave, NGW = nblk * 8;
    unsigned char* ws = a.ws;
    {
        LAS float* scr = (LAS float*)(lds + wave * 16384);
        constexpr int I_IN = 16 * 64, I_OUT = 16 * 32, I_1 = 16 * 128, I_2 = 64 * 32, I_L = I_IN + I_OUT + I_1 + I_2;
        for (int it = gw; it < (l1 - l0) * I_L; it += NGW) {
            const int l = l0 + it / I_L; int r = it % I_L;
            if (r < I_IN) { p0_transpose_item(a.in[8] + (size_t)l * D * PW, PW, 64, (bf16*)(ws + WS_WIN) + (size_t)l * NIN * D, D, true, scr, r, lane); continue; } r -= I_IN;
            if (r < I_OUT) { p0_transpose_item(a.in[9] + (size_t)l * D * D, D, 32, (bf16*)(ws + WS_WOUT) + (size_t)l * D * D, D, false, scr, r, lane); continue; } r -= I_OUT;
            if (r < I_1) { p0_transpose_item(a.in[16] + (size_t)l * D * FF, FF, 128, (bf16*)(ws + WS_W1) + (size_t)l * FF * D, D, false, scr, r, lane); continue; } r -= I_1;
            p0_transpose_item(a.in[17] + (size_t)l * FF * D, D, 32, (bf16*)(ws + WS_W2) + (size_t)l * D * FF, FF, false, scr, r, lane);
        }
    }
    __syncthreads();
    {
        LAS float* Wl = (LAS float*)lds;
        LAS float* tbl = (LAS float*)(lds + 16384);
        LAS float* CWl = (LAS float*)(lds + 20480);
        LAS float* Wk = (LAS float*)(lds + 40960);
        LAS bf16* outl = (LAS bf16*)(lds + 61440);
        for (int it = wblk; it < (l1 - l0) * 4 * 2 * 16; it += nblk) {
            const int ks = it & 15, trig = (it >> 4) & 1, g = (it >> 5) & 3, l = l0 + (it >> 7);
            const float* Wf = a.in[15] + ((size_t)(l * 4 + g)) * 4096;
            for (int i = tid; i < 4096; i += 512) Wl[i] = Wf[i];
            if (tid < 64) { float sv, cv; sv = sinpif((float)tid * (1.0f / 32.0f)); cv = cospif((float)tid * (1.0f / 32.0f)); tbl[tid] = (trig ? sv : cv) * 0.125f; }
            const float* wsrc = a.in[8] + (size_t)l * D * PW + (size_t)(ks * 64) * PW + 2048 + 64 * g;
            for (int i = tid; i < 4096; i += 512) { const int kk = i >> 6, c = i & 63; Wk[kk * 65 + c] = wsrc[(size_t)kk * PW + c]; }
            __syncthreads();
            { const int d = tid & 63;
#pragma unroll 1
              for (int i = 0; i < 8; ++i) { const int c = (tid >> 6) + 8 * i; float s = 0.f;
#pragma unroll 8
                  for (int m = 0; m < 64; ++m) s += tbl[(c * m) & 63] * Wl[m * 64 + d];
                  CWl[c * 65 + d] = s; } }
            __syncthreads();
            { const int d = tid & 63;
#pragma unroll 1
              for (int i = 0; i < 8; ++i) { const int kk = (tid >> 6) + 8 * i; float s = 0.f;
#pragma unroll 8
                  for (int c = 0; c < 64; ++c) s += Wk[kk * 65 + c] * CWl[c * 65 + d];
                  outl[d * 64 + kk] = (bf16)(pk2(s, 0.f) & 0xffffu); } }
            __syncthreads();
            { const int d = tid >> 3, ch = tid & 7;
              const int row = 256 * (8 + trig) + 128 * (d >> 5) + 32 * g + (d & 31);
              const u32x4 v = *(const LAS u32x4*)(outl + d * 64 + ch * 8);
              *(u32x4*)((bf16*)(ws + WS_WIN) + (size_t)l * NIN * D + (size_t)row * D + ks * 64 + ch * 8) = v; }
            __syncthreads();
        }
    }
}

DI void p0_prep(const Args& a, LAS unsigned char* lds) {
    const int tid = tid_opaque(), lane = tid & 63, wave = tid >> 6, G = gridDim.x, bid = blockIdx.x;
    const int gw = bid * 8 + wave, NGW = G * 8;
    unsigned char* ws = a.ws;
    if (bid == 0) { unsigned* ctl = (unsigned*)(ws + WS_CTL); for (int i = tid; i < 16384; i += 512) ctl[i] = 0u; }
    { float* rss = (float*)(ws + WS_RSS); for (int i = bid * 512 + tid; i < 2 * DEPTH * M; i += G * 512) rss[i] = 0.f; }
    p0_weights(a, lds, 0, 1, bid, G);
    __syncthreads();
    {
        LAS float* sc = (LAS float*)lds;
        LAS float* red = (LAS float*)(lds + 81920);
        bool staged = false;
        for (int it = bid; it < DEPTH * 192; it += G) {
            if (!staged) {
                for (int i = tid; i < 17 * 1024; i += 512) { const float v = (i < 16 * 1024) ? a.in[1][i] : a.in[3][i - 16 * 1024]; sc[(i & 1023) * 20 + (i >> 10)] = v / (1.f + __expf(-v)); }
                staged = true; __syncthreads();
            }
            const int l = it / 192, cb = it % 192, col = tid & 31, kg = tid >> 5, n = cb * 32 + col;
            const float* wp = a.in[4] + (size_t)l * D * 6144 + (size_t)(kg * 64) * 6144 + n;
            float acc[17];
#pragma unroll
            for (int r = 0; r < 17; ++r) acc[r] = 0.f;
#pragma unroll 1
            for (int kk0 = 0; kk0 < 64; kk0 += 16) { float wv[16];
#pragma unroll
                for (int u = 0; u < 16; ++u) wv[u] = wp[(size_t)(kk0 + u) * 6144];
#pragma unroll
                for (int u = 0; u < 16; ++u) { const LAS f32x4* sp = (const LAS f32x4*)(sc + (kg * 64 + kk0 + u) * 20);
                    const f32x4 s0 = sp[0], s1 = sp[1], s2 = sp[2], s3 = sp[3]; const float s4 = sc[(kg * 64 + kk0 + u) * 20 + 16];
                    acc[0] += s0.x * wv[u]; acc[1] += s0.y * wv[u]; acc[2] += s0.z * wv[u]; acc[3] += s0.w * wv[u];
                    acc[4] += s1.x * wv[u]; acc[5] += s1.y * wv[u]; acc[6] += s1.z * wv[u]; acc[7] += s1.w * wv[u];
                    acc[8] += s2.x * wv[u]; acc[9] += s2.y * wv[u]; acc[10] += s2.z * wv[u]; acc[11] += s2.w * wv[u];
                    acc[12] += s3.x * wv[u]; acc[13] += s3.y * wv[u]; acc[14] += s3.z * wv[u]; acc[15] += s3.w * wv[u];
                    acc[16] += s4 * wv[u]; } }
#pragma unroll
            for (int r = 0; r < 17; ++r) red[(kg * 17 + r) * 32 + col] = acc[r];
            __syncthreads();
            for (int o = tid; o < 17 * 32; o += 512) { const int r = o >> 5, cc = o & 31; float sm = a.in[5][l * 6144 + cb * 32 + cc];
#pragma unroll
                for (int k16 = 0; k16 < 16; ++k16) sm += red[(k16 * 17 + r) * 32 + cc];
                ((float*)(ws + WS_MOD))[((size_t)l * 17 + r) * 6144 + cb * 32 + cc] = sm; }
            __syncthreads();
        }
    }
    {
        const int gt = bid * 512 + tid, NT = G * 512;
        LAS f32x2_t* ctab = (LAS f32x2_t*)lds;
        __syncthreads();
        for (int r = tid; r < 2048; r += 512) { const float ang = (float)r * (1.0f / 1024.0f); ctab[r] = (f32x2_t){cospif(ang) * 0.02209708691207961f, sinpif(ang) * 0.02209708691207961f}; }
        __syncthreads();
        bf16* Dl = (bf16*)(ws + WS_DFTL);
        for (int idx = gt; idx < 2048 * 512; idx += NT) { const int k = idx >> 9, kk0 = (idx & 511) * 8; unsigned w[4];
#pragma unroll
            for (int e = 0; e < 8; e += 2) { float v[2];
#pragma unroll
                for (int q = 0; q < 2; ++q) { const int kk = kk0 + e + q, li = kk & 2047, tr = kk >> 11; const f32x2_t cs = ctab[(k * li) & 2047]; v[q] = tr ? -cs.y : cs.x; }
                w[e >> 1] = pk2(v[0], v[1]); }
            *(u32x4*)(Dl + (size_t)k * 4096 + kk0) = (u32x4){w[0], w[1], w[2], w[3]}; }
        bf16* Dc = (bf16*)(ws + WS_DFTC);
        for (int idx = gt; idx < 256 * 64; idx += NT) { const int k = idx >> 6, kk0 = (idx & 63) * 8; unsigned w[4];
#pragma unroll
            for (int e = 0; e < 8; e += 2) { float v[2];
#pragma unroll
                for (int q = 0; q < 2; ++q) { const int kk = kk0 + e + q, li = kk & 255, tr = kk >> 8; const f32x2_t cs = ctab[((k * li) & 255) * 8]; v[q] = (tr ? -cs.y : cs.x) * 2.8284271247461903f; }
                w[e >> 1] = pk2(v[0], v[1]); }
            *(u32x4*)(Dc + (size_t)k * 512 + kk0) = (u32x4){w[0], w[1], w[2], w[3]}; }
        __syncthreads();
        float2* axt = (float2*)(ws + WS_AXT); float2* rt = (float2*)(ws + WS_RT);
        for (int idx = gt; idx < 64 * 16; idx += NT) { const int pos = idx >> 4, i = idx & 15; const float fr = exp2f(-(float)i * (13.287712379549449f / 16.0f)); const float ang = (float)pos * fr; float sv, cv; sv = sinpif(ang * 0.3183098861837907f); cv = cospif(ang * 0.3183098861837907f); axt[idx] = make_float2(cv, sv); }
        for (int idx = gt; idx < 2048 * 32; idx += NT) { const int pos = idx >> 5, i = idx & 31; const float fr = exp2f(-(float)i * (13.287712379549449f / 32.0f)); const float ang = (float)pos * fr; float sv, cv; sv = sinpif(ang * 0.3183098861837907f); cv = cospif(ang * 0.3183098861837907f); rt[idx] = make_float2(cv, sv); }
    }
}


DI void p0_bias(const Args& a, LAS unsigned char* lds, int l0, int l1, int wblk, int nblk) {
    const int tid = tid_opaque(), lane = tid & 63, wave = tid >> 6;
    const int gw = wblk * 8 + wave, NGW = nblk * 8;
    unsigned char* ws = a.ws;
    const float* modb = (const float*)(ws + WS_MOD);
    {
        float* b1 = (float*)(ws + WS_BIAS); float* b2 = b1 + (size_t)DEPTH * 17 * NIN;
        LAS float* shl = (LAS float*)lds;
#pragma unroll 1
        for (int g8 = 2 * l0; g8 < 2 * l1; ++g8) {
            const int l = g8 >> 1; const bool isw1 = g8 & 1; const int N = isw1 ? FF : NIN;
            __syncthreads();
            for (int i = tid; i < 17 * 1024; i += 512) shl[i] = modb[(size_t)l * 17 * 6144 + (size_t)(i >> 10) * 6144 + (isw1 ? 3 : 0) * 1024 + (i & 1023)];
            __syncthreads();
            const bf16* wbase = isw1 ? (const bf16*)(ws + WS_W1) + (size_t)l * FF * D : (const bf16*)(ws + WS_WIN) + (size_t)l * NIN * D;
#pragma unroll 1
            for (int nn = gw; nn < N; nn += NGW) {
                const bf16* wrow = wbase + (size_t)nn * D + lane * 4;
                const u32x2 w0 = *(const u32x2*)(wrow), w1 = *(const u32x2*)(wrow + 256), w2 = *(const u32x2*)(wrow + 512), w3 = *(const u32x2*)(wrow + 768);
                float res = 0.f;
                int ln = lane; asm volatile("" : "+v"(ln));
#pragma unroll 2
                for (int r = 0; r < 17; ++r) { const LAS f32x4* sp = (const LAS f32x4*)(shl + r * 1024 + ln * 4); const f32x4 s0 = sp[0], s1 = sp[64], s2 = sp[128], s3 = sp[192];
                    float d = bflo(w0.x) * s0.x + bfhi(w0.x) * s0.y + bflo(w0.y) * s0.z + bfhi(w0.y) * s0.w + bflo(w1.x) * s1.x + bfhi(w1.x) * s1.y + bflo(w1.y) * s1.z + bfhi(w1.y) * s1.w
                            + bflo(w2.x) * s2.x + bfhi(w2.x) * s2.y + bflo(w2.y) * s2.z + bfhi(w2.y) * s2.w + bflo(w3.x) * s3.x + bfhi(w3.x) * s3.y + bflo(w3.y) * s3.z + bfhi(w3.y) * s3.w;
                    d = wave_sum(d); if (lane == r) res = d; }
                if (lane < 17) { if (isw1) b2[((size_t)l * 17 + lane) * FF + nn] = res; else b1[((size_t)l * 17 + lane) * NIN + nn] = res; }
            }
        }
    }
    __syncthreads();
}

DI void p0b_prep(const Args& a, LAS unsigned char* lds) {
    const int tid = tid_opaque(), lane = tid & 63, wave = tid >> 6, G = gridDim.x, bid = blockIdx.x;
    const int gw = bid * 8 + wave, NGW = G * 8;
    unsigned char* ws = a.ws;
    const float* modb = (const float*)(ws + WS_MOD);
    {
        float* gs = (float*)(ws + WS_GS);
        for (int idx = bid * 512 + tid; idx < DEPTH * 2 * 17 * 1024; idx += G * 512) { const int col = idx & 1023, rr = idx >> 10, r = rr % 17, lw = rr / 17, which = lw & 1, l = lw >> 1;
            const float g = (which ? a.in[7] : a.in[6])[l * D + col]; const float sc = modb[((size_t)l * 17 + r) * 6144 + (which ? 4 : 1) * 1024 + col]; gs[idx] = g * (1.f + sc); }
    }
    p0_bias(a, lds, 0, 1, bid, G);
    {
        const float* g = a.in[6]; bf16* A = (bf16*)(ws + WS_A); float* rss = (float*)(ws + WS_RSS);
        for (int r = gw; r < M; r += NGW) {
            const bool lat = r < NLAT; const float* xr = lat ? a.in[0] + (size_t)r * D : a.in[2] + (size_t)(r - NLAT) * D; const int bi = lat ? (r >> 11) : 16;
            const float* mp = modb + (size_t)bi * 6144 + 1024;
            f32x4 v[4]; float s = 0.f;
#pragma unroll
            for (int j = 0; j < 4; ++j) { v[j] = ((const f32x4*)xr)[lane + 64 * j]; s += (v[j].x * v[j].x + v[j].y * v[j].y) + (v[j].z * v[j].z + v[j].w * v[j].w); }
            s = wave_sum(s); if (lane == 0) rss[r] = s;
#pragma unroll
            for (int j = 0; j < 4; ++j) { const f32x4 gv = ((const f32x4*)g)[lane + 64 * j], sc = ((const f32x4*)mp)[lane + 64 * j]; const f32x4 y = v[j] * gv * (sc + 1.0f);
                ((u32x2*)(A + (size_t)r * D))[lane + 64 * j] = (u32x2){pk2(y.x, y.y), pk2(y.z, y.w)}; }
        }
    }
}

DI void norm_phase(const float* xl, const float* xc, const float* g, const float* mod, int shift_i, int scale_i, bf16* A, int rows) {
    const int tid = tid_opaque(), lane = tid & 63, gw = blockIdx.x * 8 + (tid >> 6), NGW = gridDim.x * 8;
    for (int r = gw; r < rows; r += NGW) {
        const bool lat = r < NLAT; const float* xr = lat ? xl + (size_t)r * D : xc + (size_t)(r - NLAT) * D; const int bi = lat ? (r >> 11) : 16;
        const float* mp = mod + (size_t)bi * 6144;
        f32x4 v[4]; float s = 0.f;
#pragma unroll
        for (int j = 0; j < 4; ++j) { v[j] = ((const f32x4*)xr)[lane + 64 * j]; s += (v[j].x * v[j].x + v[j].y * v[j].y) + (v[j].z * v[j].z + v[j].w * v[j].w); }
        const float rs = 1.0f / sqrtf(wave_sum(s) * (1.0f / D) + 1e-6f);
#pragma unroll
        for (int j = 0; j < 4; ++j) {
            const f32x4 gv = ((const f32x4*)g)[lane + 64 * j], sh = ((const f32x4*)(mp + shift_i * 1024))[lane + 64 * j], sc = ((const f32x4*)(mp + scale_i * 1024))[lane + 64 * j];
            const f32x4 y = v[j] * rs * gv * (sc + 1.0f) + sh;
            ((u32x2*)(A + (size_t)r * D))[lane + 64 * j] = (u32x2){pk2(y.x, y.y), pk2(y.z, y.w)};
        }
    }
}

struct OneUnit {
    pg8::Unit u;
    DI bool next(int i, pg8::Unit& o) const { if (i != 0) return false; o = u; return true; }
    DI void a_ready(const pg8::Unit&) const {}
    DI void done(const pg8::Unit&) const {}
};

struct EpiWin {
    static constexpr bool PERM = false, AFTER_DRAIN = false;
    unsigned char* ws_; const AS4 Args* ap_; int l_;
    DI void operator()(const f32x4 (&acc)[2][2][4][2], const pg8::Unit& u, int wr, int wc, int fr, int fq) const {
        asm volatile("" : "+v"(fr), "+v"(fq));
        const int pn = u.pn;
        unsigned char* ws = ws_; const AS4 Args* ap = ap_; int l = l_;
        asm volatile("" : "+s"(ws), "+s"(ap), "+s"(l));
        bf16* P = (bf16*)(ws + WS_P); bf16* TTl = (bf16*)(ws + WS_TTL); bf16* TTc = (bf16*)(ws + WS_TTC);
        const float* qg = ap->in[10] + l * 64; const float* kg = ap->in[11] + l * 64;
        const float2* axt = (const float2*)(ws + WS_AXT); const float2* rt = (const float2*)(ws + WS_RT);
        const float* rss = (const float*)(ws + WS_RSS) + (size_t)(2 * l) * M;
        const float* bias = (const float*)(ws + WS_BIAS) + (size_t)l * 17 * NIN;
        int kind; float scl = 1.f; const float* gptr = qg;
        if (pn < 2) { kind = 1; scl = 0.125f * LOG2E; }
        else if (pn == 2) { if (wc < 2) { kind = 1; gptr = kg; } else kind = 0; }
        else if (pn == 3) kind = 2;
        else if (pn == 4) { kind = 2; scl = 0.125f; }
        else if (pn == 5) kind = 0;
        else if (pn < 8) kind = 3;
        else kind = 4;
        const bool lat = u.pm < (NLAT / 256);
        f32x4 bvv[2][2];
        { const float* bp = bias + (size_t)(lat ? ((u.pm * 256) >> 11) : 16) * NIN + 256 * pn + 32 * wc + 4 * fq;
#pragma unroll
          for (int bj = 0; bj < 2; ++bj)
#pragma unroll
          for (int n = 0; n < 2; ++n) bvv[bj][n] = *(const f32x4*)(bp + 128 * bj + 16 * n); }
#pragma unroll
        for (int ai = 0; ai < 2; ++ai)
#pragma unroll
        for (int m = 0; m < 4; ++m) {
            const int row = u.pm * 256 + ai * 128 + wr * 64 + m * 16 + fr;
            const int t = lat ? (row & 2047) : (row & 255);
            float v[2][2][4];
            const float rsd = 1.0f / sqrtf(rss[row] * (1.0f / 1024.0f) + 1e-6f);
#pragma unroll
            for (int bj = 0; bj < 2; ++bj)
#pragma unroll
            for (int n = 0; n < 2; ++n) { const f32x4 bv = bvv[bj][n];
#pragma unroll
                for (int e = 0; e < 4; ++e) v[bj][n][e] = acc[ai][bj][m][n][e] * rsd + bv[e]; }
            if (kind == 1) {
                float ss = 0.f;
#pragma unroll
                for (int bj = 0; bj < 2; ++bj)
#pragma unroll
                for (int n = 0; n < 2; ++n)
#pragma unroll
                for (int e = 0; e < 4; ++e) ss += v[bj][n][e] * v[bj][n][e];
                ss += __shfl_xor(ss, 16); ss += __shfl_xor(ss, 32);
                const float rs = 1.0f / sqrtf(ss * (1.0f / 64.0f) + 1e-6f);
#pragma unroll
                for (int bj = 0; bj < 2; ++bj)
#pragma unroll
                for (int n = 0; n < 2; ++n) { const f32x4 gv = *(const f32x4*)(gptr + 32 * bj + 16 * n + 4 * fq);
#pragma unroll
                    for (int e = 0; e < 4; ++e) v[bj][n][e] *= rs * gv[e]; }
                if (lat) {
#pragma unroll
                    for (int bj = 0; bj < 2; ++bj) { const int pos = bj ? (t & 63) : (t >> 6);
#pragma unroll
                        for (int e = 0; e < 4; ++e) { const float2 cs = axt[pos * 16 + 4 * fq + e]; const float x1 = v[bj][0][e], x2 = v[bj][1][e];
                            v[bj][0][e] = x1 * cs.x - x2 * cs.y; v[bj][1][e] = x2 * cs.x + x1 * cs.y; } }
                }
            } else if (kind == 2) {
                if (lat) {
#pragma unroll
                    for (int n = 0; n < 2; ++n)
#pragma unroll
                    for (int e = 0; e < 4; ++e) { const float2 cs = rt[t * 32 + 16 * n + 4 * fq + e]; const float x1 = v[0][n][e], x2 = v[1][n][e];
                        v[0][n][e] = x1 * cs.x - x2 * cs.y; v[1][n][e] = x2 * cs.x + x1 * cs.y; }
                }
            } else if (kind == 3) {
#pragma unroll
                for (int bj = 0; bj < 2; ++bj)
#pragma unroll
                for (int n = 0; n < 2; ++n)
#pragma unroll
                for (int e = 0; e < 4; ++e) { const float x = v[bj][n][e]; v[bj][n][e] = x / (1.0f + __expf(-x)); }
            }
            if (kind != 4) {
                bf16* rp = P + (size_t)row * PC + 256 * pn + 64 * wc + 4 * fq;
#pragma unroll
                for (int bj = 0; bj < 2; ++bj)
#pragma unroll
                for (int n = 0; n < 2; ++n)
                    *(u32x2*)(rp + 32 * bj + 16 * n) = (u32x2){pk2(v[bj][n][0] * scl, v[bj][n][1] * scl), pk2(v[bj][n][2] * scl, v[bj][n][3] * scl)};
            } else {
                const int trig = pn - 8;
                bf16* tp = lat ? TTl + ((size_t)((row >> 11) * 256)) * 4096 + trig * 2048 + t : TTc + ((size_t)(((row - NLAT) >> 8) * 256)) * 512 + trig * 256 + t;
                const size_t pitch = lat ? 4096 : 512;
#pragma unroll
                for (int bj = 0; bj < 2; ++bj)
#pragma unroll
                for (int n = 0; n < 2; ++n)
#pragma unroll
                for (int e = 0; e < 4; ++e) { const int nch = 64 * wc + 32 * bj + 16 * n + 4 * fq + e; tp[(size_t)nch * pitch] = (bf16)(pk2(v[bj][n][e], 0.f) & 0xffffu); }
            }
        }
    }
};

template <bool XS> struct EpiRes {
    static constexpr bool PERM = false, AFTER_DRAIN = false;
    unsigned char* ws_; const AS4 Args* ap_; int l_; int ff2_;
    DI void operator()(const f32x4 (&acc)[2][2][4][2], const pg8::Unit& u, int wr, int wc, int fr, int fq) const {
        asm volatile("" : "+v"(fr), "+v"(fq));
        const bool lat = u.pm < (NLAT / 256);
        unsigned char* ws = ws_; const AS4 Args* ap = ap_; int l = l_, ff2 = ff2_;
        asm volatile("" : "+s"(ws), "+s"(ap), "+s"(l), "+s"(ff2));
        float* out_lat = ap->out; float* out_ctx = (float*)(ws + WS_XC);
        const float* base_lat = (l == 0 && !ff2) ? ap->in[0] : out_lat; const float* base_ctx = (l == 0 && !ff2) ? ap->in[2] : out_ctx;
        const float* gate = (const float*)(ws + WS_MOD) + (size_t)l * 17 * 6144 + (ff2 ? 5 : 2) * 1024;
        bf16* xs = (bf16*)(ws + WS_A);
        const float* gs = (const float*)(ws + WS_GS) + (size_t)((ff2 ? (l + 1) * 2 : l * 2 + 1) * 17) * 1024;
        float* rss = (float*)(ws + WS_RSS) + (size_t)(ff2 ? 2 * l + 2 : 2 * l + 1) * M;
        const int bi = lat ? ((u.pm * 256) >> 11) : 16;
        f32x4 gvv[2][2], gsvv[2][2];
#pragma unroll
        for (int bj = 0; bj < 2; ++bj)
#pragma unroll
        for (int n = 0; n < 2; ++n) { const int col = u.pn * 256 + bj * 128 + wc * 32 + n * 16 + 4 * fq;
            gvv[bj][n] = *(const f32x4*)(gate + (size_t)bi * 6144 + col); gsvv[bj][n] = XS ? *(const f32x4*)(gs + bi * 1024 + col) : (f32x4){0.f, 0.f, 0.f, 0.f}; }
        const int row00 = u.pm * 256 + wr * 64 + fr, colb = u.pn * 256 + wc * 32 + 4 * fq;
        const float* bp0 = lat ? base_lat + (size_t)row00 * D + colb : base_ctx + (size_t)(row00 - NLAT) * D + colb;
#pragma unroll
        for (int am = 0; am < 4; ++am) { const int ai = am >> 1;
        f32x4 bvv[4][2][2];
#pragma unroll
        for (int m = (am & 1) * 2; m < (am & 1) * 2 + 2; ++m)
#pragma unroll
        for (int bj = 0; bj < 2; ++bj)
#pragma unroll
        for (int n = 0; n < 2; ++n) bvv[m][bj][n] = *(const f32x4*)(bp0 + (size_t)(ai * 128 + m * 16) * D + bj * 128 + n * 16);
#pragma unroll
        for (int m = (am & 1) * 2; m < (am & 1) * 2 + 2; ++m) {
            const int row = u.pm * 256 + ai * 128 + wr * 64 + m * 16 + fr;
            float* op = lat ? out_lat + (size_t)row * D : out_ctx + (size_t)(row - NLAT) * D;
            float ssq = 0.f;
#pragma unroll
            for (int bj = 0; bj < 2; ++bj)
#pragma unroll
            for (int n = 0; n < 2; ++n) { const int col = u.pn * 256 + bj * 128 + wc * 32 + n * 16 + 4 * fq;
                const f32x4 bv = bvv[m][bj][n], gv = gvv[bj][n];
                const f32x4 o = bv + gv * acc[ai][bj][m][n];
                *(f32x4*)(op + col) = o;
                if (XS) { const f32x4 gsv = gsvv[bj][n]; const f32x4 y = o * gsv;
                    ssq += (o.x * o.x + o.y * o.y) + (o.z * o.z + o.w * o.w);
                    *(u32x2*)(xs + (size_t)row * D + col) = (u32x2){pk2(y.x, y.y), pk2(y.z, y.w)}; } }
            if (XS) { ssq += __shfl_xor(ssq, 16); ssq += __shfl_xor(ssq, 32);
                if (fq == 0) (void)__hip_atomic_fetch_add(rss + row, ssq, __ATOMIC_RELAXED, __HIP_MEMORY_SCOPE_AGENT); }
        }
        }
    }
};

template <int ACT  , bool DFT, bool NORM  > struct EpiB16 {
    static constexpr bool PERM = true, AFTER_DRAIN = false;
    unsigned char* ws_; size_t o_off; int ldc; int rows_per_b; int row_base; int col_base; int l_;
    DI void operator()(const f32x4 (&acc)[2][2][4][2], const pg8::Unit& u, int wr, int wc, int fr, int fq) const {
        asm volatile("" : "+v"(fr), "+v"(fq));
        unsigned char* ws = ws_; int l = l_; asm volatile("" : "+s"(ws), "+s"(l));
        bf16* O = (bf16*)(ws + o_off);
        const float* rss = (const float*)(ws + WS_RSS) + (size_t)(2 * l + 1) * M;
        const float* bias = (const float*)(ws + WS_BIAS) + (size_t)DEPTH * 17 * NIN + (size_t)l * 17 * FF;
        const int row0 = (DFT ? row_base + u.pn * rows_per_b + u.pm * 256 : u.pm * 256) + wr * 64 + fr;
        const int col0 = (DFT ? col_base : u.pn * 256) + wc * 32 + 8 * fq;
        f32x4 bvv[2][2];
        if (NORM) { const float* bp = bias + (size_t)(u.pm < (NLAT / 256) ? ((u.pm * 256) >> 11) : 16) * ldc + col0;
#pragma unroll
            for (int bj = 0; bj < 2; ++bj) { bvv[bj][0] = *(const f32x4*)(bp + bj * 128); bvv[bj][1] = *(const f32x4*)(bp + bj * 128 + 4); } }
#pragma unroll
        for (int ai = 0; ai < 2; ++ai)
#pragma unroll
        for (int m = 0; m < 4; ++m) { const int row = row0 + ai * 128 + m * 16; bf16* rowp = O + (size_t)row * ldc + col0;
            float rsd = 1.f;
            if (NORM) rsd = 1.0f / sqrtf(rss[row] * (1.0f / 1024.0f) + 1e-6f);
#pragma unroll
            for (int bj = 0; bj < 2; ++bj) { f32x4 v0 = acc[ai][bj][m][0], v1 = acc[ai][bj][m][1];
                if (NORM) { v0 = v0 * rsd + bvv[bj][0]; v1 = v1 * rsd + bvv[bj][1]; }
                if (ACT == 1) {
#pragma unroll
                    for (int e = 0; e < 4; ++e) { const float a0 = fmaxf(v0[e], 0.f), a1 = fmaxf(v1[e], 0.f); v0[e] = a0 * a0; v1[e] = a1 * a1; } }
                u32x4 w; w.x = pk2(v0[0], v0[1]); w.y = pk2(v0[2], v0[3]); w.z = pk2(v1[0], v1[1]); w.w = pk2(v1[2], v1[3]);
                *(u32x4*)(rowp + bj * 128) = w; } }
    }
};

DI float xhalf_max(float v) { const auto rr = __builtin_amdgcn_permlane32_swap(__float_as_uint(v), __float_as_uint(v), false, false); return fmaxf(__uint_as_float(rr[0]), __uint_as_float(rr[1])); }
DI float xhalf_sum(float v) { const auto rr = __builtin_amdgcn_permlane32_swap(__float_as_uint(v), __float_as_uint(v), false, false); return __uint_as_float(rr[0]) + __uint_as_float(rr[1]); }
constexpr int TROW = 144;
DI void attn_item(LAS unsigned char* lds, const bf16* P, bf16* Y, const float* sink, int item, bool ctxq) {
    const int tid = tid_opaque(), lane = tid & 63, w = tid >> 6, h = lane >> 5, r32 = lane & 31;
    int b, n, kvh, hp, qrow0, ulo, uhi;
    if (!ctxq) { hp = item & 1; kvh = (item >> 1) & 1; n = (item >> 2) & 15; b = item >> 6; qrow0 = b * SEQ + n * 128; ulo = (n == 0) ? 2 : 0; uhi = (n == 15) ? 4 : 6; }
    else { hp = item & 1; kvh = (item >> 1) & 1; n = (item >> 2) & 1; b = item >> 3; qrow0 = NLAT + b * LCTX + n * 128; ulo = 0; uhi = 0; }
    const int cnt = 4 + (uhi - ulo);
    const int hq = 4 * kvh + 2 * hp + (w >> 2), iloc = 32 * (w & 3) + r32, qrow = qrow0 + iloc;
    bf16x8 bq[4];
#pragma unroll
    for (int s = 0; s < 4; ++s) bq[s] = *(const bf16x8*)(P + (size_t)qrow * PC + C_AQ + hq * 64 + 16 * s + 8 * h);
    float m_run = sink[hq] * LOG2E, l_run = 1.0f;
    f32x16 O0 = zero16(), O1 = zero16();
    const int lkey = tid >> 3, lch = tid & 7;
    const int ctxrow0 = NLAT + b * LCTX;
#define ATT_TILE_ROW(q_) ((q_) < 4 ? ctxrow0 + 64 * (q_) : b * SEQ + (n - 1 + (((q_) - 4 + ulo) >> 1)) * 128 + 64 * (((q_) - 4 + ulo) & 1))
    u32x4 kreg, vreg;
    { const int kr = ATT_TILE_ROW(0) + lkey; const bf16* gp = P + (size_t)kr * PC + kvh * 64 + lch * 8; kreg = *(const u32x4*)(gp + C_AK); vreg = *(const u32x4*)(gp + C_AV); }
    *(LAS u32x4*)(lds + lkey * TROW + lch * 16) = kreg; *(LAS u32x4*)(lds + 18432 + lkey * TROW + lch * 16) = vreg;
    __syncthreads();
    const int i16 = lane & 15, tq = i16 >> 2, tp = i16 & 3, blk = (lane >> 4) & 1;
    for (int q = 0; q < cnt; ++q) {
        const int buf = q & 1;
        if (q + 1 < cnt) { const int kr = ATT_TILE_ROW(q + 1) + lkey; const bf16* gp = P + (size_t)kr * PC + kvh * 64 + lch * 8; kreg = *(const u32x4*)(gp + C_AK); vreg = *(const u32x4*)(gp + C_AV); }
        const LAS unsigned char* Kb = lds + buf * 9216; const LAS unsigned char* Vb = lds + 18432 + buf * 9216;
        f32x16 S0 = zero16(), S1 = zero16();
        bf16x8 kf[8];
#pragma unroll
        for (int s = 0; s < 4; ++s) { kf[2 * s] = *(const LAS bf16x8*)(Kb + r32 * TROW + (16 * s + 8 * h) * 2); kf[2 * s + 1] = *(const LAS bf16x8*)(Kb + (32 + r32) * TROW + (16 * s + 8 * h) * 2); }
        s16x4 tv[2][8];
#pragma unroll
        for (int dvt = 0; dvt < 2; ++dvt) { const LAS unsigned char* vb = Vb + (4 * h + tq) * TROW + (32 * dvt + 16 * blk + 4 * tp) * 2;
#pragma unroll
            for (int i = 0; i < 8; ++i) tv[dvt][i] = tr_read(vb + 8 * i * TROW); }
        __builtin_amdgcn_sched_barrier(0);
#pragma unroll
        for (int s = 0; s < 4; ++s) { S0 = MFMA32(kf[2 * s], bq[s], S0); S1 = MFMA32(kf[2 * s + 1], bq[s], S1); }
        int mk = 0, joff = 0;
        if (q >= 4) { const int u = q - 4 + ulo; mk = (u >> 1) == 0 ? 1 : ((u >> 1) == 2 ? 2 : 0); joff = 64 * (u & 1); }
        if (mk) {
#pragma unroll
            for (int r = 0; r < 16; ++r) { const int j0 = joff + crow(r, h), j1 = j0 + 32;
                const bool v0 = (mk == 1) ? (j0 >= iloc) : (j0 <= iloc), v1 = (mk == 1) ? (j1 >= iloc) : (j1 <= iloc);
                S0[r] = v0 ? S0[r] : -1e30f; S1[r] = v1 ? S1[r] : -1e30f; }
        }
        float mx = fmaxf(S0[0], S1[0]);
#pragma unroll
        for (int r = 1; r < 16; ++r) mx = fmaxf(mx, fmaxf(S0[r], S1[r]));
        mx = xhalf_max(mx);
        const float mnew = fmaxf(m_run, mx), alpha = ex2(m_run - mnew); m_run = mnew;
        float rs = 0.f;
#pragma unroll
        for (int r = 0; r < 16; ++r) { S0[r] = ex2(S0[r] - mnew); S1[r] = ex2(S1[r] - mnew); rs += S0[r] + S1[r]; }
        rs = xhalf_sum(rs);
        l_run = l_run * alpha + rs;
#pragma unroll
        for (int r = 0; r < 16; ++r) { O0[r] *= alpha; O1[r] *= alpha; }
        const bf16x8 p00 = pack8(S0, 0), p01 = pack8(S0, 1), p10 = pack8(S1, 0), p11 = pack8(S1, 1);
#pragma unroll
        for (int dvt = 0; dvt < 2; ++dvt) {
            const bf16x8 a00 = cat8(tv[dvt][0], tv[dvt][1]);
            const bf16x8 a01 = cat8(tv[dvt][2], tv[dvt][3]);
            const bf16x8 a10 = cat8(tv[dvt][4], tv[dvt][5]);
            const bf16x8 a11 = cat8(tv[dvt][6], tv[dvt][7]);
            if (dvt == 0) { O0 = MFMA32(a00, p00, O0); O0 = MFMA32(a01, p01, O0); O0 = MFMA32(a10, p10, O0); O0 = MFMA32(a11, p11, O0); }
            else          { O1 = MFMA32(a00, p00, O1); O1 = MFMA32(a01, p01, O1); O1 = MFMA32(a10, p10, O1); O1 = MFMA32(a11, p11, O1); }
        }
        __builtin_amdgcn_sched_barrier(0);
        if (q + 1 < cnt) { *(LAS u32x4*)(lds + (buf ^ 1) * 9216 + lkey * TROW + lch * 16) = kreg; *(LAS u32x4*)(lds + 18432 + (buf ^ 1) * 9216 + lkey * TROW + lch * 16) = vreg; }
        __syncthreads();
    }
#undef ATT_TILE_ROW
    const float inv = 1.0f / l_run;
    bf16* yp = Y + (size_t)qrow * D + hq * 64 + 4 * h;
#pragma unroll
    for (int g4 = 0; g4 < 4; ++g4) {
        *(u32x2*)(yp + 8 * g4) = (u32x2){pk2(O0[4 * g4] * inv, O0[4 * g4 + 1] * inv), pk2(O0[4 * g4 + 2] * inv, O0[4 * g4 + 3] * inv)};
        *(u32x2*)(yp + 32 + 8 * g4) = (u32x2){pk2(O1[4 * g4] * inv, O1[4 * g4 + 1] * inv), pk2(O1[4 * g4 + 2] * inv, O1[4 * g4 + 3] * inv)};
    }
}

DI float log2gamma(const float* logit, int dir, int hd) { const float x = logit[dir * 4 + hd]; return -log1pf(expf(-x)) * LOG2E; }
DI int chunk_row0(int b, int c) { return c < 2 ? NLAT + b * LCTX + 128 * c : b * SEQ + 128 * (c - 2); }
DI int ord_b(int c) { return c < 2 ? 1 - c : 19 - c; }

DI void load_tile128(LAS unsigned char* dst, const bf16* src  , int tid) {
#pragma unroll
    for (int i = 0; i < 2; ++i) { const int idx = tid + 512 * i, row = idx >> 3, ch = idx & 7;
        *(LAS u32x4*)(dst + row * TROW + ch * 16) = *(const u32x4*)(src + (size_t)row * PC + ch * 8); }
}

struct RsPre { u32x4 k0, k1, v0, v1; };
DI void ret_state_fetch(RsPre& r, const bf16* P, int item, int tid) {
    const int c = item % NCH, hd = (item / NCH) & 3, b = item / (NCH * 4);
    const bf16* src = P + (size_t)chunk_row0(b, c) * PC + hd * 64 + (size_t)(tid >> 3) * PC + (tid & 7) * 8;
    r.k0 = *(const u32x4*)(src + C_RK); r.k1 = *(const u32x4*)(src + (size_t)64 * PC + C_RK);
    r.v0 = *(const u32x4*)(src + C_RV); r.v1 = *(const u32x4*)(src + (size_t)64 * PC + C_RV);
}
DI void ret_state_item(LAS unsigned char* lds, const RsPre& pre, float* KV, const float* logit, int item) {
    const int tid = tid_opaque(), lane = tid & 63, w = tid >> 6, hh = lane >> 5, r32 = lane & 31;
    const int c = item % NCH, hd = (item / NCH) & 3, b = item / (NCH * 4);
    const int row0 = chunk_row0(b, c);
    LAS unsigned char* Kl = lds; LAS unsigned char* Vl = lds + 18432; LAS float* zl = (LAS float*)(lds + 36864);
    { const unsigned to = (tid >> 3) * TROW + (tid & 7) * 16;
      *(LAS u32x4*)(Kl + to) = pre.k0; *(LAS u32x4*)(Kl + 64 * TROW + to) = pre.k1; *(LAS u32x4*)(Vl + to) = pre.v0; *(LAS u32x4*)(Vl + 64 * TROW + to) = pre.v1; }
    if (tid < 256) { const int dir = tid >> 7, j = tid & 127; const float lg = log2gamma(logit, dir, hd); zl[tid] = ex2((float)(dir ? j : 127 - j) * lg); }
    __syncthreads();
    const int dir = w >> 2, dvt = (w >> 1) & 1, dkt = w & 1;
    const int i16 = lane & 15, tq = i16 >> 2, tp = i16 & 3, blk = (lane >> 4) & 1;
    f32x16 acc = zero16();
    s16x4 tvv[8][2], tkk[8][2]; f32x4 zz[8][2];
#pragma unroll
    for (int s = 0; s < 8; ++s) {
        const LAS unsigned char* vb = Vl + (16 * s + 8 * hh + tq) * TROW + (32 * dvt + 16 * blk + 4 * tp) * 2;
        const LAS unsigned char* kb = Kl + (16 * s + 8 * hh + tq) * TROW + (32 * dkt + 16 * blk + 4 * tp) * 2;
        tvv[s][0] = tr_read(vb); tvv[s][1] = tr_read(vb + 4 * TROW); tkk[s][0] = tr_read(kb); tkk[s][1] = tr_read(kb + 4 * TROW);
        const LAS f32x4* zp = (const LAS f32x4*)(zl + dir * 128 + 16 * s + 8 * hh); zz[s][0] = zp[0]; zz[s][1] = zp[1];
    }
    __builtin_amdgcn_sched_barrier(0);
#pragma unroll
    for (int s = 0; s < 8; ++s) {
        const bf16x8 av = cat8(tvv[s][0], tvv[s][1]);
        const bf16x8 kr = cat8(tkk[s][0], tkk[s][1]);
        u32x4 kk; kk.x = pk2(bf2f(kr[0]) * zz[s][0].x, bf2f(kr[1]) * zz[s][0].y); kk.y = pk2(bf2f(kr[2]) * zz[s][0].z, bf2f(kr[3]) * zz[s][0].w);
        kk.z = pk2(bf2f(kr[4]) * zz[s][1].x, bf2f(kr[5]) * zz[s][1].y); kk.w = pk2(bf2f(kr[6]) * zz[s][1].z, bf2f(kr[7]) * zz[s][1].w);
        acc = MFMA32(av, __builtin_bit_cast(bf16x8, kk), acc);
    }
    float* op = KV + ((size_t)(((b * 4 + hd) * 2 + dir) * NCH + c)) * 4096 + 32 * dkt + r32;
#pragma unroll
    for (int r = 0; r < 16; ++r) op[(32 * dvt + crow(r, hh)) * 64] = acc[r];
    __syncthreads();
}

DI void ret_scan_item(const float* KV, bf16* SS, const float* logit, int item) {
    const int tid = tid_opaque();
    const int half = item & 1, dir = (item >> 1) & 1, hd = (item >> 2) & 3, b = item >> 4;
    const float G = ex2(128.0f * log2gamma(logit, dir, hd));
    const size_t base = (size_t)(((b * 4 + hd) * 2 + dir) * NCH) * 4096 + half * 2048 + tid * 4;
    f32x4 v[NCH];
#pragma unroll
    for (int c = 0; c < NCH; ++c) v[c] = *(const f32x4*)(KV + base + (size_t)c * 4096);
    f32x4 S = (f32x4){0.f, 0.f, 0.f, 0.f};
    if (dir == 0) {
#pragma unroll
        for (int c = 0; c < NCH; ++c) { *(u32x2*)(SS + base + (size_t)c * 4096) = (u32x2){pk2(S.x, S.y), pk2(S.z, S.w)}; S = S * G + v[c]; }
    } else {
#pragma unroll
        for (int o = 0; o < NCH; ++o) { const int c = (o < 2) ? 1 - o : 19 - o;
            *(u32x2*)(SS + base + (size_t)c * 4096) = (u32x2){pk2(S.x, S.y), pk2(S.z, S.w)}; S = S * G + v[c]; }
    }
}

struct RetPre { u32x4 q0, q1, k0, k1, v0, v1, s0, s1; };
DI void ret_out_fetch(RetPre& r, const bf16* P, const bf16* SS, int item, int tid) {
    const int c = item % NCH, hd = (item / NCH) & 3, b = item / (NCH * 4);
    const bf16* src = P + (size_t)chunk_row0(b, c) * PC + hd * 64 + (size_t)(tid >> 3) * PC + (tid & 7) * 8;
    r.q0 = *(const u32x4*)(src + C_RQ); r.q1 = *(const u32x4*)(src + (size_t)64 * PC + C_RQ);
    r.k0 = *(const u32x4*)(src + C_RK); r.k1 = *(const u32x4*)(src + (size_t)64 * PC + C_RK);
    r.v0 = *(const u32x4*)(src + C_RV); r.v1 = *(const u32x4*)(src + (size_t)64 * PC + C_RV);
    const bf16* sf = SS + ((size_t)(((b * 4 + hd) * 2 + 0) * NCH + c)) * 4096 + tid * 8;
    r.s0 = *(const u32x4*)sf; r.s1 = *(const u32x4*)(sf + (size_t)NCH * 4096);
}
DI void ret_out_item(LAS unsigned char* lds, const bf16* P, const RetPre& pre, bf16* Y, const float* logit, const float* gng, int item) {
    const int tid = tid_opaque(), lane = tid & 63, w = tid >> 6, hh = lane >> 5, r32 = lane & 31;
    const int c = item % NCH, hd = (item / NCH) & 3, b = item / (NCH * 4);
    const int row0 = chunk_row0(b, c);
    LAS unsigned char* Ql = lds; LAS unsigned char* Kl = lds + 18432; LAS unsigned char* Vl = lds + 36864; LAS unsigned char* St = lds + 55296; LAS float* X = (LAS float*)(lds + 73728);
    { const unsigned to = (tid >> 3) * TROW + (tid & 7) * 16;
      *(LAS u32x4*)(Ql + to) = pre.q0; *(LAS u32x4*)(Ql + 64 * TROW + to) = pre.q1;
      *(LAS u32x4*)(Kl + to) = pre.k0; *(LAS u32x4*)(Kl + 64 * TROW + to) = pre.k1;
      *(LAS u32x4*)(Vl + to) = pre.v0; *(LAS u32x4*)(Vl + 64 * TROW + to) = pre.v1;
      const int e = tid * 8, dv = e >> 6, dk = e & 63;
      *(LAS u32x4*)(St + dv * TROW + dk * 2) = pre.s0; *(LAS u32x4*)(St + 9216 + dv * TROW + dk * 2) = pre.s1; }
    __syncthreads();
    const int dir = w >> 2, rt = w & 3, iloc = 32 * rt + r32;
    const float lg = log2gamma(logit, dir, hd);
    const int i16 = lane & 15, tq = i16 >> 2, tp = i16 & 3, blk = (lane >> 4) & 1;
    u32x2 gwv[4][2];
    { const bf16* gp = P + (size_t)(row0 + iloc) * PC + (dir ? C_GB : C_GF) + hd * 64 + 4 * hh;
#pragma unroll
      for (int g4 = 0; g4 < 4; ++g4) { gwv[g4][0] = *(const u32x2*)(gp + 8 * g4); gwv[g4][1] = *(const u32x2*)(gp + 32 + 8 * g4); } }
    const float* gn = gng + hd * 64 + 4 * hh;
    bf16x8 bq[4];
#pragma unroll
    for (int s = 0; s < 4; ++s) bq[s] = *(const LAS bf16x8*)(Ql + iloc * TROW + (16 * s + 8 * hh) * 2);
    f32x16 O0 = zero16(), O1 = zero16();
    { bf16x8 sa[8];
#pragma unroll
      for (int s = 0; s < 4; ++s) { sa[2 * s] = *(const LAS bf16x8*)(St + dir * 9216 + r32 * TROW + (16 * s + 8 * hh) * 2); sa[2 * s + 1] = *(const LAS bf16x8*)(St + dir * 9216 + (32 + r32) * TROW + (16 * s + 8 * hh) * 2); }
      __builtin_amdgcn_sched_barrier(0);
#pragma unroll
      for (int s = 0; s < 4; ++s) { O0 = MFMA32(sa[2 * s], bq[s], O0); O1 = MFMA32(sa[2 * s + 1], bq[s], O1); } }
    { const float xi = ex2((float)(dir ? 128 - iloc : iloc + 1) * lg);
#pragma unroll
      for (int r = 0; r < 16; ++r) { O0[r] *= xi; O1[r] *= xi; } }
    const int jlo = dir ? rt : 0, jhi = dir ? 3 : rt;
    for (int jt = jlo; jt <= jhi; ++jt) {
        f32x16 S = zero16();
        bf16x8 kf[4]; s16x4 tv[2][4];
#pragma unroll
        for (int s = 0; s < 4; ++s) kf[s] = *(const LAS bf16x8*)(Kl + (32 * jt + r32) * TROW + (16 * s + 8 * hh) * 2);
#pragma unroll
        for (int dvt = 0; dvt < 2; ++dvt) { const LAS unsigned char* vb = Vl + (32 * jt + 4 * hh + tq) * TROW + (32 * dvt + 16 * blk + 4 * tp) * 2;
#pragma unroll
            for (int i = 0; i < 4; ++i) tv[dvt][i] = tr_read(vb + 8 * i * TROW); }
        __builtin_amdgcn_sched_barrier(0);
#pragma unroll
        for (int s = 0; s < 4; ++s) S = MFMA32(kf[s], bq[s], S);
#pragma unroll
        for (int r = 0; r < 16; ++r) { const int j = 32 * jt + crow(r, hh); const int dd = dir ? j - iloc : iloc - j; S[r] = dd >= 0 ? S[r] * ex2((float)dd * lg) : 0.f; }
        const bf16x8 p0 = pack8(S, 0), p1 = pack8(S, 1);
#pragma unroll
        for (int dvt = 0; dvt < 2; ++dvt) {
            const bf16x8 a0 = cat8(tv[dvt][0], tv[dvt][1]);
            const bf16x8 a1 = cat8(tv[dvt][2], tv[dvt][3]);
            if (dvt == 0) { O0 = MFMA32(a0, p0, O0); O0 = MFMA32(a1, p1, O0); } else { O1 = MFMA32(a0, p0, O1); O1 = MFMA32(a1, p1, O1); }
        }
    }
    float sm = 0.f;
#pragma unroll
    for (int r = 0; r < 16; ++r) sm += O0[r] + O1[r];
    sm += __shfl_xor(sm, 32);
    const float mu = sm * (1.0f / 64.0f);
    float sq = 0.f;
#pragma unroll
    for (int r = 0; r < 16; ++r) { const float d0 = O0[r] - mu, d1 = O1[r] - mu; sq += d0 * d0 + d1 * d1; }
    sq += __shfl_xor(sq, 32);
    const float rstd = 1.0f / sqrtf(sq * (1.0f / 64.0f) + 1e-6f);
#pragma unroll
    for (int g4 = 0; g4 < 4; ++g4) {
        { const u32x2 gw = gwv[g4][0]; const f32x4 gv = *(const f32x4*)(gn + 8 * g4);
          O0[4 * g4] = (O0[4 * g4] - mu) * rstd * gv.x * bflo(gw.x); O0[4 * g4 + 1] = (O0[4 * g4 + 1] - mu) * rstd * gv.y * bfhi(gw.x);
          O0[4 * g4 + 2] = (O0[4 * g4 + 2] - mu) * rstd * gv.z * bflo(gw.y); O0[4 * g4 + 3] = (O0[4 * g4 + 3] - mu) * rstd * gv.w * bfhi(gw.y); }
        { const u32x2 gw = gwv[g4][1]; const f32x4 gv = *(const f32x4*)(gn + 32 + 8 * g4);
          O1[4 * g4] = (O1[4 * g4] - mu) * rstd * gv.x * bflo(gw.x); O1[4 * g4 + 1] = (O1[4 * g4 + 1] - mu) * rstd * gv.y * bfhi(gw.x);
          O1[4 * g4 + 2] = (O1[4 * g4 + 2] - mu) * rstd * gv.z * bflo(gw.y); O1[4 * g4 + 3] = (O1[4 * g4 + 3] - mu) * rstd * gv.w * bfhi(gw.y); }
    }
    LAS float* xp = X + iloc * 68 + 4 * hh;
    if (dir == 1) {
#pragma unroll
        for (int g4 = 0; g4 < 4; ++g4) { *(LAS f32x4*)(xp + 8 * g4) = (f32x4){O0[4 * g4], O0[4 * g4 + 1], O0[4 * g4 + 2], O0[4 * g4 + 3]};
            *(LAS f32x4*)(xp + 32 + 8 * g4) = (f32x4){O1[4 * g4], O1[4 * g4 + 1], O1[4 * g4 + 2], O1[4 * g4 + 3]}; }
    }
    __syncthreads();
    if (dir == 0) {
        bf16* yp = Y + (size_t)(row0 + iloc) * D + 512 + hd * 64 + 4 * hh;
#pragma unroll
        for (int g4 = 0; g4 < 4; ++g4) { const f32x4 x0 = *(const LAS f32x4*)(xp + 8 * g4), x1 = *(const LAS f32x4*)(xp + 32 + 8 * g4);
            *(u32x2*)(yp + 8 * g4) = (u32x2){pk2(O0[4 * g4] + x0.x, O0[4 * g4 + 1] + x0.y), pk2(O0[4 * g4 + 2] + x0.z, O0[4 * g4 + 3] + x0.w)};
            *(u32x2*)(yp + 32 + 8 * g4) = (u32x2){pk2(O1[4 * g4] + x1.x, O1[4 * g4 + 1] + x1.y), pk2(O1[4 * g4 + 2] + x1.z, O1[4 * g4 + 3] + x1.w)}; }
    }
    __syncthreads();
}
#define XB_TMO      128
#define XB_XCNT(j)  (256  + 64 * (j))
#define XB_XSUB(j)  (1280 + 64 * (j))
#define XB_XGEN(j)  (2304 + 64 * (j))
#define XB_TOP      3328
#define XB_TOPGEN   3392
#define XCD_BAR_WORDS 3456
#define XB_SPIN_CAP (1u << 18)

__device__ __forceinline__ unsigned xb_ld(unsigned* p)              { return __hip_atomic_load(p, __ATOMIC_RELAXED, __HIP_MEMORY_SCOPE_AGENT); }
__device__ __forceinline__ unsigned xb_add(unsigned* p, unsigned v) { return __hip_atomic_fetch_add(p, v, __ATOMIC_RELAXED, __HIP_MEMORY_SCOPE_AGENT); }
__device__ __forceinline__ unsigned xb_xcc_id() { return (unsigned)__builtin_amdgcn_s_getreg((3 << 11) | 20) & 0xFu; }
#define XB_SPIN(cond, bar) do { unsigned _sp = 0; while (cond) { __builtin_amdgcn_s_sleep(1); \
    if ((++_sp & 255u) == 0u) { if (xb_ld(&(bar)[XB_TMO])) break; if (_sp > XB_SPIN_CAP) { atomicAdd(&(bar)[XB_TMO], 1u); break; } } } } while (0)

struct XcdBarrier {
    unsigned* bar; unsigned x;
    volatile LAS unsigned* st;
};

__device__ __forceinline__ XcdBarrier xcd_barrier_post(unsigned* bar, volatile LAS unsigned* st) {
    XcdBarrier b; b.bar = bar; b.x = xb_xcc_id(); b.st = st;
    if (threadIdx.x == 0) (void)xb_add(&bar[XB_XCNT(b.x)], 1u);
    return b;
}
__device__ __forceinline__ void xcd_barrier_complete(unsigned* bar, unsigned x, unsigned& nloc, unsigned& nx) {
    const unsigned G = gridDim.x * gridDim.y * gridDim.z;
    unsigned sum, cnt, mine, sp = 0u;
    for (;;) {
        sum = 0u; cnt = 0u; mine = 0u;
#pragma unroll
        for (unsigned j = 0; j < 16; ++j) { const unsigned c = xb_ld(&bar[XB_XCNT(j)]); sum += c; cnt += (c > 0u) ? 1u : 0u; mine = (j == x) ? c : mine; }
        if (sum == G) break;
        __builtin_amdgcn_s_sleep(1);
        if ((++sp & 255u) == 0u) { if (xb_ld(&bar[XB_TMO])) break; if (sp > XB_SPIN_CAP) { atomicAdd(&bar[XB_TMO], 1u); break; } }
    }
    nloc = mine > 0u ? mine : 1u; nx = cnt > 0u ? cnt : 1u;
}

__device__ __forceinline__ void xcd_barrier(const XcdBarrier& b) {
    asm volatile("s_waitcnt vmcnt(0)" ::: "memory");
    __syncthreads();
    if (threadIdx.x == 0) {
        unsigned* bar = b.bar;
        __builtin_amdgcn_s_waitcnt(0);
        unsigned nloc = b.st[0], nx = b.st[1];
        if (nloc == 0u) { xcd_barrier_complete(bar, b.x, nloc, nx); b.st[0] = nloc; b.st[1] = nx; }
        const unsigned old = xb_add(&bar[XB_XSUB(b.x)], 1u);
        const unsigned gen = old / nloc;
        if (old + 1u == (gen + 1u) * nloc) {
            __builtin_amdgcn_fence(__ATOMIC_RELEASE, "agent");
            asm volatile("s_waitcnt vmcnt(0)" ::: "memory");
            const unsigned og = xb_add(&bar[XB_TOP], 1u);
            const unsigned tg = og / nx;
            if (og + 1u == (tg + 1u) * nx) xb_add(&bar[XB_TOPGEN], 1u);
            else XB_SPIN(xb_ld(&bar[XB_TOPGEN]) == tg, bar);
            __builtin_amdgcn_fence(__ATOMIC_ACQUIRE, "agent");
            xb_add(&bar[XB_XGEN(b.x)], 1u);
            asm volatile("s_waitcnt vmcnt(0)" ::: "memory");
        } else {
            XB_SPIN(xb_ld(&bar[XB_XGEN(b.x)]) == gen, bar);
            __builtin_amdgcn_fence(__ATOMIC_ACQUIRE, "agent");
            asm volatile("s_waitcnt vmcnt(0)" ::: "memory");
        }
    }
    __syncthreads();
}

#ifndef USE_XCD_BAR
#define USE_XCD_BAR 1
#endif
#ifndef REPEAT_FF1
#define REPEAT_FF1 1
#endif
#ifndef REPEAT_G3
#define REPEAT_G3 1
#endif
#ifndef REPEAT_MIX
#define REPEAT_MIX 1
#endif
#ifndef PHMASK
#define PHMASK 0x1ff
#endif
constexpr int NSTEPS = 2 + 7 * DEPTH;
__global__ void __launch_bounds__(512, 2) mega_fwd(Args a_) {
    extern __shared__ __attribute__((aligned(16))) unsigned char lds_raw[];
    LAS unsigned char* lds = (LAS unsigned char*)lds_raw;
    cg::grid_group grid = cg::this_grid();
    const int step_lo = a_.lo, step_hi = a_.hi;
    volatile LAS unsigned* MISC = (volatile LAS unsigned*)(lds + LDS_ITEM + 64);
    if (threadIdx.x < 2) MISC[threadIdx.x] = 0u;
    __syncthreads();
    for (int step = step_lo; step < step_hi; ++step) {
        if (step > step_lo) {
#if USE_XCD_BAR
            unsigned* barw = (unsigned*)(a_.ws + WS_CTL) + 8192;
            if (step == step_lo + 1) { grid.sync(); (void)xcd_barrier_post(barw, MISC); }
            else { XcdBarrier xb; xb.bar = barw; xb.x = xb_xcc_id(); xb.st = MISC; xcd_barrier(xb); }
#else
            grid.sync();
#endif
        }
        const AS4 Args* ap = (const AS4 Args*)__builtin_amdgcn_kernarg_segment_ptr();
        asm volatile("" : "+s"(ap));
        Args a;
#pragma unroll
        for (int i = 0; i < 18; ++i) a.in[i] = ap->in[i];
        a.out = ap->out; a.ws = ap->ws; a.lo = step_lo; a.hi = step_hi;
        unsigned char* ws = a.ws;
        int G_ = gridDim.x, bid_ = blockIdx.x; asm volatile("" : "+s"(G_), "+s"(bid_));
        const int tid = tid_opaque(), G = G_, bid = bid_;
        bf16* Abuf = (bf16*)(ws + WS_A); bf16* Pbuf = (bf16*)(ws + WS_P); bf16* Hbuf = (bf16*)(ws + WS_H);
        bf16* TTl = (bf16*)(ws + WS_TTL); bf16* TTc = (bf16*)(ws + WS_TTC); float* KV = (float*)(ws + WS_KV);
        float* xc = (float*)(ws + WS_XC);
        if (step == 0) { if (PHMASK & 256) p0_prep(a, lds); continue; }
        if (step == 1) { if (PHMASK & 256) p0b_prep(a, lds); continue; }
        const int l = (step - 2) / 7; int ph = (step - 2) % 7;
        bf16* SSbuf = (bf16*)(ws + WS_TTL);
        if (ph == 2) {
            if ((PHMASK >> 1) & 1) for (int it = bid; it < NB * 4 * 2 * 2; it += G) ret_scan_item(KV, SSbuf, a.in[13] + l * 8, it);
            continue;
        }
        if (ph > 2) --ph;
        const bool last = (l == DEPTH - 1);
        bf16* Ybuf = (bf16*)(ws + WS_Y);
        const int rows = last ? NLAT : M;
        if (!((PHMASK >> ph) & 1)) continue;
        if (ph == 0) {
            pg8::Gemm g{Abuf, (const bf16*)(ws + WS_WIN) + (size_t)l * NIN * D, M, NIN, D}; pg8::StaticOrder S; S.init(M, NIN, G, bid); S.rev = (l > 0) ? 1 : 0;
            EpiWin E{ws, ap, l};
            for (int rep = 0; rep < REPEAT_G3; ++rep)
            pg8::gemm_phase<EpiWin, pg8::StaticOrder, true, true>(lds, g, S, E);
        } else if (ph == 1) {
            for (int rep = 0; rep < REPEAT_MIX; ++rep) {
            unsigned* ctr = (unsigned*)(ws + WS_CTL) + 64 * l + 1024 * rep;
            const int n0 = 128, n1 = n0 + 1024, n2 = n1 + (last ? 0 : 16), n3 = n2 + (last ? 0 : 128), n4 = n3 + NB * 4 * NCH / 4;
            volatile LAS int* slot = (volatile LAS int*)(lds + LDS_ITEM);
            int nextit = 0; if (tid == 0) nextit = (int)atomicAdd(ctr, 1u);
            for (;;) {
                __syncthreads();
                if (tid == 0) *slot = nextit;
                __syncthreads();
                const int it = *slot;
                if (it >= n4) break;
                if (tid == 0) nextit = (int)atomicAdd(ctr, 1u);
                if (it < n0) {
                    pg8::Gemm g{(const bf16*)(ws + WS_DFTL), TTl, 2048, 256, 4096}; OneUnit S; S.u.pm = it & 7; S.u.pn = it >> 3;
                    EpiB16<0, true, false> E{ws, WS_Y, D, SEQ, 0, 768, 0};
                    pg8::gemm_phase<EpiB16<0, true, false>, OneUnit, false, true>(lds, g, S, E);
                } else if (it < n1) {
                    attn_item(lds, Pbuf, Ybuf, a.in[12] + l * 8, it - n0, false);
                } else if (it < n2) {
                    pg8::Gemm g{(const bf16*)(ws + WS_DFTC), TTc, 256, 256, 512}; OneUnit S; S.u.pm = 0; S.u.pn = it - n1;
                    EpiB16<0, true, false> E{ws, WS_Y, D, LCTX, NLAT, 768, 0};
                    pg8::gemm_phase<EpiB16<0, true, false>, OneUnit, false, true>(lds, g, S, E);
                } else if (it < n3) {
                    attn_item(lds, Pbuf, Ybuf, a.in[12] + l * 8, it - n2, true);
                } else {
                    const int i0 = (it - n3) * 4;
                    RsPre cur{}; ret_state_fetch(cur, Pbuf, i0, tid);
#pragma unroll 1
                    for (int s4 = 0; s4 < 4; ++s4) { RsPre nxt = cur; if (s4 < 3) ret_state_fetch(nxt, Pbuf, i0 + s4 + 1, tid);
                        ret_state_item(lds, cur, KV, a.in[13] + l * 8, i0 + s4); cur = nxt; }
                }
            }
            }
        } else if (ph == 2) {
            for (int rep = 0; rep < REPEAT_MIX; ++rep) {
                const int NIT = NB * 4 * NCH;
                int it = bid; while (it < NIT && last && (it % NCH) < 2) it += G;
                RetPre cur{}; if (it < NIT) ret_out_fetch(cur, Pbuf, SSbuf, it, tid);
                while (it < NIT) {
                    int nx = it + G; while (nx < NIT && last && (nx % NCH) < 2) nx += G;
                    RetPre nxt = cur; if (nx < NIT) ret_out_fetch(nxt, Pbuf, SSbuf, nx, tid);
                    ret_out_item(lds, Pbuf, cur, Ybuf, a.in[13] + l * 8, a.in[14] + l * 256, it);
                    cur = nxt; it = nx;
                }
            }
        } else if (ph == 3) {
            pg8::Gemm g{Ybuf, (const bf16*)(ws + WS_WOUT) + (size_t)l * D * D, rows, D, D}; pg8::StaticOrder S; S.init(rows, D, G, bid);
            EpiRes<true> E{ws, ap, l, 0};
            if (REPEAT_G3 > 1) { EpiB16<0, false, false> E2{ws, WS_P, D, 0, 0, 0, 0}; pg8::gemm_phase<EpiB16<0, false, false>, pg8::StaticOrder, true, true>(lds, g, S, E2); }
            pg8::gemm_phase<EpiRes<true>, pg8::StaticOrder, true, true>(lds, g, S, E);
            if (!last) {
                const int first = ((rows / 256) * (D / 256)) % G;
                if (bid >= first) p0_weights(a, lds, l + 1, l + 2, bid - first, G - first);
            }
        } else if (ph == 4) {
            pg8::Gemm g{Abuf, (const bf16*)(ws + WS_W1) + (size_t)l * FF * D, rows, FF, D}; pg8::StaticOrder S; S.init(rows, FF, G, bid); S.rev = 1;
            EpiB16<1, false, true> E{ws, WS_H, FF, 0, 0, 0, l};
            for (int rep = 0; rep < REPEAT_FF1; ++rep)
            pg8::gemm_phase<EpiB16<1, false, true>, pg8::StaticOrder, true, true>(lds, g, S, E);
        } else {
            pg8::Gemm g{Hbuf, (const bf16*)(ws + WS_W2) + (size_t)l * D * FF, rows, D, FF}; pg8::StaticOrder S; S.init(rows, D, G, bid);
            if (REPEAT_G3 > 1) { EpiB16<0, false, false> E2{ws, WS_A, D, 0, 0, 0, 0}; pg8::gemm_phase<EpiB16<0, false, false>, pg8::StaticOrder, true, true>(lds, g, S, E2); }
            if (!last) { EpiRes<true> E{ws, ap, l, 1};
                pg8::gemm_phase<EpiRes<true>, pg8::StaticOrder, true, true>(lds, g, S, E);
                const int first = ((rows / 256) * (D / 256)) % G;
                if (bid >= first) p0_bias(a, lds, l + 1, l + 2, bid - first, G - first); }
            else { EpiRes<false> E{ws, ap, l, 1};
                pg8::gemm_phase<EpiRes<false>, pg8::StaticOrder, true, true>(lds, g, S, E); }
        }
    }
}
}

extern "C" void kernel_launch(void* const* d_in, const int* in_sizes, int n_in, void* d_out, int out_size, void* d_ws, size_t ws_size, hipStream_t stream) {
    using namespace mk;
    static int grid = 0;
    if (grid == 0) {
        if (n_in != 18 || in_sizes[0] != NLAT * D || out_size != NLAT * D || ws_size < WS_END) { fprintf(stderr, "kernel_launch: unexpected shapes (n_in %d, out %d, ws %zu)\n", n_in, out_size, ws_size); grid = -1; return; }
        int dev = 0, cus = 0, per_cu = 0;
        (void)hipGetDevice(&dev);
        (void)hipDeviceGetAttribute(&cus, hipDeviceAttributeMultiprocessorCount, dev);
        if (hipFuncSetAttribute((const void*)mega_fwd, hipFuncAttributeMaxDynamicSharedMemorySize, LDS_BYTES) != hipSuccess) { fprintf(stderr, "kernel_launch: hipFuncSetAttribute failed\n"); grid = -1; return; }
        if (hipOccupancyMaxActiveBlocksPerMultiprocessor(&per_cu, (const void*)mega_fwd, 512, LDS_BYTES) != hipSuccess || per_cu < 1) { fprintf(stderr, "kernel_launch: occupancy query gave %d\n", per_cu); per_cu = 1; }
        (void)hipGetLastError();
        grid = cus * per_cu;
    }
    if (grid < 0) return;
    Args a{};
    for (int i = 0; i < 18; ++i) a.in[i] = (const float*)d_in[i];
    a.out = (float*)d_out; a.ws = (unsigned char*)d_ws;
#if ONE_LAUNCH
    a.lo = 0; a.hi = NSTEPS;
    void* args[] = {&a};
    hipError_t e = hipLaunchCooperativeKernel((const void*)mega_fwd, dim3(grid), dim3(512), args, LDS_BYTES, stream);
    if (e != hipSuccess) fprintf(stderr, "cooperative launch failed: %s (grid %d)\n", hipGetErrorString(e), grid);
#else
    for (int s = 0; s < NSTEPS; ++s) { a.lo = s; a.hi = s + 1; hipLaunchKernelGGL(mega_fwd, dim3(grid), dim3(512), LDS_BYTES, stream, a); }
#endif
}
```

```cpp
#include <hip/hip_runtime.h>
#include <hip/hip_cooperative_groups.h>
#include <cstdio>
#include <cstdint>
namespace cg = cooperative_groups;
#ifndef ONE_LAUNCH
#define ONE_LAUNCH 1
#endif
namespace pg8 {
#define PG8_LAS __attribute__((address_space(3)))
typedef unsigned short bf16_t;
typedef short bf16x8 __attribute__((ext_vector_type(8)));
typedef float f32x4 __attribute__((ext_vector_type(4)));
typedef unsigned u32x4 __attribute__((ext_vector_type(4)));
constexpr int BM = 256, BK = 64, HALF = 128, HTB = HALF * BK * 2  , STAGE_BYTES = 8 * HTB, NXCD = 8, WGM = 8;

__host__ __device__ __forceinline__ int lds_byte(int r, int c) { const int st = (r >> 4) * 2 + (c >> 5), rr = r & 15, cc = c & 31, ob = rr * 64 + cc * 2; return st * 1024 + (ob ^ (((ob >> 9) & 1) << 5)); }
__host__ __device__ __forceinline__ void stage_rc(int b, int& R, int& C) { const int st = b / 1024, sb = b % 1024, swz = sb ^ (((sb >> 9) & 1) << 5); R = (st >> 1) * 16 + swz / 64; C = (st & 1) * 32 + (swz % 64) / 2; }
__host__ __device__ __forceinline__ int perm32(int rho) { const int n = rho >> 4, i = rho & 15; return 8 * (i >> 2) + 4 * n + (i & 3); }

struct Unit { int pm, pn; };
struct Gemm { const bf16_t* A; const bf16_t* Bt; int M, N, K; };

struct StaticOrder {
    int nM, nN, nwg, G, c, rev = 0;
    __host__ __device__ void init(int M, int N, int G_, int c_) { nM = M / BM; nN = N / BM; nwg = nM * nN; G = G_; c = c_; }
    __host__ __device__ bool next(int i, Unit& u) const {
        const long L = (long)i * G + c; if (L >= nwg) return false;
        int wgid = (int)L; { const int q = nwg / NXCD, r = nwg % NXCD, xcd = wgid % NXCD, off = wgid / NXCD; wgid = (xcd < r ? xcd * (q + 1) : r * (q + 1) + (xcd - r) * q) + off; }
        const int nig = WGM * nN, gid = wgid / nig, fm = gid * WGM, gsz = (nM - fm) < WGM ? (nM - fm) : WGM;
        u.pm = fm + ((wgid % nig) % gsz); u.pn = (wgid % nig) / gsz; if (rev) u.pm = nM - 1 - u.pm; return true;
    }
    __device__ __forceinline__ void a_ready(const Unit&) const {}
    __device__ __forceinline__ void done(const Unit&) const {}
};

__device__ __forceinline__ unsigned cvt_pk_bf16(float lo, float hi) { unsigned r; asm volatile("v_cvt_pk_bf16_f32 %0, %1, %2" : "=v"(r) : "v"(lo), "v"(hi)); return r; }
template <class Epi, class Sched, bool ALIGN_EPI = false, bool SP2 = false>
__device__ __forceinline__ void gemm_phase(PG8_LAS unsigned char* lds, const Gemm g, const Sched& S, const Epi& E) {
    int tid_ = threadIdx.x; asm volatile("" : "+v"(tid_));
    const int tid = tid_, wid = __builtin_amdgcn_readfirstlane(tid >> 6), lane = tid & 63, wr = wid >> 2, wc = wid & 3, fr = lane & 15, fq = lane >> 4;
    const int K = g.K, nt = K / BK;
    unsigned voffA[2], voffB[2];
#pragma unroll
    for (int i = 0; i < 2; ++i) { int R, C; stage_rc(tid * 16 + i * 8192, R, C); const int Rb = Epi::PERM ? ((R & ~31) + perm32(R & 31)) : R;
        voffA[i] = (unsigned)(R * K + C) * 2u; voffB[i] = (unsigned)(Rb * K + C) * 2u; }
    const size_t kstep = (size_t)(BK * 2);
    const size_t hstep = (size_t)HALF * K * 2;
    const size_t tstep = 2 * hstep;
    const unsigned ldsw = (unsigned)wid * 1024u;
    const int aoff = lds_byte(wr * 64 + fr, fq * 8), boff = lds_byte(wc * 32 + fr, fq * 8);
#define PG8_SA(b, h) (((b) * 2 + (h)) * HTB)
#define PG8_SB(b, h) ((4 + (b) * 2 + (h)) * HTB)
#define PG8_STAGE(bufoff, gbase, voff) do { _Pragma("unroll") for (int _i = 0; _i < 2; ++_i) \
        __builtin_amdgcn_global_load_lds((const unsigned*)((const char*)(gbase) + (voff)[_i]), (PG8_LAS unsigned*)(lds + (bufoff) + ldsw + _i * 8192), 16, 0, 0); } while (0)
#define PG8_LDA(dst, b, h) do { _Pragma("unroll") for (int m = 0; m < 4; ++m) _Pragma("unroll") for (int k = 0; k < 2; ++k) dst[m][k] = *(const PG8_LAS bf16x8*)(lds + PG8_SA(b, h) + aoff + m * 2048 + k * 1024); } while (0)
#define PG8_LDB(dst, b, h) do { _Pragma("unroll") for (int n = 0; n < 2; ++n) _Pragma("unroll") for (int k = 0; k < 2; ++k) dst[n][k] = *(const PG8_LAS bf16x8*)(lds + PG8_SB(b, h) + boff + n * 2048 + k * 1024); } while (0)
#define PG8_MMA(ai, bj, At, Bt) do { __builtin_amdgcn_s_setprio(1); _Pragma("unroll") for (int m = 0; m < 4; ++m) _Pragma("unroll") for (int n = 0; n < 2; ++n) _Pragma("unroll") for (int k = 0; k < 2; ++k) \
        acc[ai][bj][m][n] = __builtin_amdgcn_mfma_f32_16x16x32_bf16(Bt[n][k], At[m][k], acc[ai][bj][m][n], 0, 0, 0); __builtin_amdgcn_s_setprio(0); } while (0)
#define PG8_WAIT_V(n) asm volatile("s_waitcnt vmcnt(" #n ")" ::: "memory")
#define PG8_WAIT_L(n) asm volatile("s_waitcnt lgkmcnt(" #n ")" ::: "memory")
#define PG8_BAR __builtin_amdgcn_s_barrier()
#define PG8_SCHED __builtin_amdgcn_sched_barrier(0)
    Unit cur, nxt; int ui = 0;
    if (!S.next(0, cur)) return;
    f32x4 acc[2][2][4][2];
#pragma unroll
    for (int a = 0; a < 2; ++a)
#pragma unroll
        for (int b = 0; b < 2; ++b)
#pragma unroll
            for (int m = 0; m < 4; ++m)
#pragma unroll
                for (int n = 0; n < 2; ++n) acc[a][b][m][n] = (f32x4){0.f, 0.f, 0.f, 0.f};
    bf16x8 At[4][2], B0[2][2], B1[2][2];
    const char* cA = (const char*)g.A + (size_t)cur.pm * tstep; const char* cB = (const char*)g.Bt + (size_t)cur.pn * tstep;
    S.a_ready(cur);
    if constexpr (SP2) {
        PG8_STAGE(PG8_SB(0, 0), cB, voffB); PG8_STAGE(PG8_SB(0, 1), cB + hstep, voffB); PG8_STAGE(PG8_SA(0, 0), cA, voffA); PG8_STAGE(PG8_SA(0, 1), cA + hstep, voffA);
        if (wr == 1) PG8_BAR;
        PG8_WAIT_V(2); PG8_BAR;
        PG8_STAGE(PG8_SB(1, 0), cB + kstep, voffB); PG8_STAGE(PG8_SA(1, 0), cA + kstep, voffA); PG8_STAGE(PG8_SB(1, 1), cB + hstep + kstep, voffB);
        PG8_WAIT_V(6); PG8_BAR;
    } else {
        PG8_STAGE(PG8_SB(0, 0), cB, voffB); PG8_STAGE(PG8_SA(0, 0), cA, voffA); PG8_STAGE(PG8_SB(0, 1), cB + hstep, voffB); PG8_STAGE(PG8_SA(0, 1), cA + hstep, voffA);
        if (wr == 1) PG8_BAR;
        PG8_WAIT_V(4); PG8_BAR;
        PG8_STAGE(PG8_SB(1, 0), cB + kstep, voffB); PG8_STAGE(PG8_SA(1, 0), cA + kstep, voffA); PG8_STAGE(PG8_SB(1, 1), cB + hstep + kstep, voffB);
        PG8_WAIT_V(6); PG8_BAR;
    }
    for (;;) {
        const bool has_next = S.next(ui + 1, nxt);
        const char* nA = has_next ? (const char*)g.A + (size_t)nxt.pm * tstep : cA; const char* nB = has_next ? (const char*)g.Bt + (size_t)nxt.pn * tstep : cB;
        for (int t = 0; t < nt; t += 2) {
            const bool last = (t == nt - 2);
            const char* a1 = cA + (size_t)(t + 1) * kstep;
            const char* a2 = last ? nA : cA + (size_t)(t + 2) * kstep; const char* b2 = last ? nB : cB + (size_t)(t + 2) * kstep;
            const char* a3 = a2 + kstep; const char* b3 = b2 + kstep;
            if (last && has_next) S.a_ready(nxt);
            if constexpr (SP2) {
            PG8_LDB(B0, 0, 0); PG8_LDB(B1, 0, 1); PG8_SCHED; PG8_LDA(At, 0, 0); PG8_STAGE(PG8_SA(1, 1), a1 + hstep, voffA);
            PG8_WAIT_V(8); PG8_WAIT_L(0); PG8_BAR; PG8_MMA(0, 0, At, B0); PG8_MMA(0, 1, At, B1); PG8_BAR; PG8_SCHED;
            PG8_LDA(At, 0, 1); PG8_STAGE(PG8_SB(0, 0), b2, voffB); PG8_STAGE(PG8_SB(0, 1), b2 + hstep, voffB); PG8_STAGE(PG8_SA(0, 0), a2, voffA);
            PG8_WAIT_V(8); PG8_WAIT_L(0); PG8_BAR; PG8_MMA(1, 0, At, B0); PG8_MMA(1, 1, At, B1); PG8_BAR; PG8_SCHED;
            PG8_LDB(B0, 1, 0); PG8_LDB(B1, 1, 1); PG8_SCHED; PG8_LDA(At, 1, 0); PG8_STAGE(PG8_SA(0, 1), a2 + hstep, voffA);
            PG8_WAIT_V(8); PG8_WAIT_L(0); PG8_BAR; PG8_MMA(0, 0, At, B0); PG8_MMA(0, 1, At, B1); PG8_BAR; PG8_SCHED;
            PG8_LDA(At, 1, 1); PG8_STAGE(PG8_SB(1, 0), b3, voffB); PG8_STAGE(PG8_SB(1, 1), b3 + hstep, voffB); PG8_STAGE(PG8_SA(1, 0), a3, voffA);
            PG8_WAIT_V(8); PG8_WAIT_L(0); PG8_BAR; PG8_MMA(1, 0, At, B0); PG8_MMA(1, 1, At, B1); PG8_BAR; PG8_SCHED;
            } else {
            PG8_LDB(B0, 0, 0); PG8_SCHED; PG8_LDA(At, 0, 0); PG8_STAGE(PG8_SA(1, 1), a1 + hstep, voffA);
            PG8_WAIT_L(8); PG8_BAR; PG8_WAIT_L(0); PG8_MMA(0, 0, At, B0); PG8_BAR; PG8_SCHED;
            PG8_LDB(B1, 0, 1); PG8_STAGE(PG8_SB(0, 0), b2, voffB);
            PG8_BAR; PG8_WAIT_L(0); PG8_MMA(0, 1, At, B1); PG8_BAR;
            PG8_LDA(At, 0, 1); PG8_STAGE(PG8_SA(0, 0), a2, voffA);
            PG8_BAR; PG8_WAIT_L(0); PG8_MMA(1, 0, At, B0); PG8_BAR; PG8_SCHED;
            PG8_STAGE(PG8_SB(0, 1), b2 + hstep, voffB);
            PG8_WAIT_V(6); PG8_BAR; PG8_MMA(1, 1, At, B1); PG8_BAR;
            PG8_LDB(B0, 1, 0); PG8_SCHED; PG8_LDA(At, 1, 0); PG8_STAGE(PG8_SA(0, 1), a2 + hstep, voffA);
            PG8_WAIT_L(8); PG8_BAR; PG8_WAIT_L(0); PG8_MMA(0, 0, At, B0); PG8_BAR; PG8_SCHED;
            PG8_LDB(B1, 1, 1); PG8_STAGE(PG8_SB(1, 0), b3, voffB);
            PG8_BAR; PG8_WAIT_L(0); PG8_MMA(0, 1, At, B1); PG8_BAR;
            PG8_LDA(At, 1, 1); PG8_STAGE(PG8_SA(1, 0), a3, voffA);
            PG8_BAR; PG8_WAIT_L(0); PG8_MMA(1, 0, At, B0); PG8_BAR; PG8_SCHED;
            PG8_STAGE(PG8_SB(1, 1), b3 + hstep, voffB);
            PG8_WAIT_V(6); PG8_BAR; PG8_MMA(1, 1, At, B1); PG8_BAR;
            }
        }
        if constexpr (ALIGN_EPI) { if (wr == 0) PG8_BAR; }
        if constexpr (!Epi::AFTER_DRAIN) { E(acc, cur, wr, wc, fr, fq); S.done(cur); }
        if (!has_next) break;
#pragma unroll
        for (int a = 0; a < 2; ++a)
#pragma unroll
            for (int b = 0; b < 2; ++b)
#pragma unroll
                for (int m = 0; m < 4; ++m)
#pragma unroll
                    for (int n = 0; n < 2; ++n) acc[a][b][m][n] = (f32x4){0.f, 0.f, 0.f, 0.f};
        cur = nxt; cA = nA; cB = nB; ++ui;
        if constexpr (ALIGN_EPI) { if (wr == 1) PG8_BAR; }
    }
    PG8_WAIT_V(0);
    if constexpr (!ALIGN_EPI) { if (wr == 0) PG8_BAR; }
    PG8_BAR;
    if constexpr (Epi::AFTER_DRAIN) { E.fused(acc, cur, wr, wc, fr, fq, lds, wid, lane); S.done(cur); }
#undef PG8_SA
#undef PG8_SB
#undef PG8_STAGE
#undef PG8_LDA
#undef PG8_LDB
#undef PG8_MMA
#undef PG8_WAIT_V
#undef PG8_WAIT_L
#undef PG8_BAR
#undef PG8_SCHED
}
}

namespace mk {
#define LAS __attribute__((address_space(3)))
#define DI __device__ __forceinline__
#define AS4 __attribute__((address_space(4)))
typedef unsigned short bf16;
typedef short bf16x8 __attribute__((ext_vector_type(8)));
typedef short s16x4 __attribute__((ext_vector_type(4)));
typedef short v4i16_t __attribute__((ext_vector_type(4)));
typedef float f32x4 __attribute__((ext_vector_type(4)));
typedef float f32x16 __attribute__((ext_vector_type(16)));
typedef unsigned u32x2 __attribute__((ext_vector_type(2)));
typedef unsigned u32x4 __attribute__((ext_vector_type(4)));
typedef float f32x2_t __attribute__((ext_vector_type(2)));
typedef __bf16 bf16x2_t __attribute__((ext_vector_type(2)));

constexpr int D = 1024, NB = 16, SEQ = 2048, LCTX = 256, DEPTH = 4;
constexpr int NLAT = NB * SEQ, NCTX = NB * LCTX, M = NLAT + NCTX;
constexpr int PW = 2304, NIN = 2560, FF = 4096, PC = 2048;
constexpr int C_AQ = 0, C_AK = 512, C_AV = 640, C_RQ = 768, C_RK = 1024, C_RV = 1280, C_GF = 1536, C_GB = 1792;
constexpr int NCH = 18;
constexpr float LOG2E = 1.4426950408889634f;

constexpr size_t MiB = 1u << 20;
constexpr size_t WS_CTL = 0, WS_MOD = 1 * MiB, WS_AXT = 3 * MiB, WS_RT = 3 * MiB + 65536, WS_DFTC = 4 * MiB, WS_DFTL = 5 * MiB;
constexpr size_t WS_WIN = 21 * MiB, WS_WOUT = 41 * MiB, WS_W1 = 49 * MiB, WS_W2 = 81 * MiB, WS_XC = 113 * MiB, WS_A = 129 * MiB;
constexpr size_t WS_H = 201 * MiB, WS_P = 201 * MiB, WS_TTL = 345 * MiB, WS_TTC = 377 * MiB, WS_KV = 381 * MiB, WS_Y = 417 * MiB, WS_RSS = 489 * MiB, WS_BIAS = 491 * MiB, WS_GS = 493 * MiB, WS_END = 494 * MiB;
constexpr int LDS_BYTES = 147456, LDS_ITEM = 131072;

struct Args { const float* in[18]; float* out; unsigned char* ws; int lo, hi; };

DI unsigned pk2(float lo, float hi) { f32x2_t v = {lo, hi}; bf16x2_t b = __builtin_convertvector(v, bf16x2_t); return __builtin_bit_cast(unsigned, b); }
DI float bf2f(short x) { return __uint_as_float(((unsigned)(unsigned short)x) << 16); }
DI float bflo(unsigned w) { return __uint_as_float(w << 16); }
DI float bfhi(unsigned w) { return __uint_as_float(w & 0xffff0000u); }
DI float ex2(float x) { return __builtin_amdgcn_exp2f(x); }
DI int tid_opaque() { int t = threadIdx.x; asm volatile("" : "+v"(t)); return t; }
DI float wave_sum(float v) {
#pragma unroll
    for (int o = 1; o < 64; o <<= 1) v += __shfl_xor(v, o);
    return v;
}
#define LDS_WAIT() asm volatile("s_waitcnt lgkmcnt(0)" ::: "memory")
#define MFMA32(a, b, c) __builtin_amdgcn_mfma_f32_32x32x16_bf16((a), (b), (c), 0, 0, 0)
DI s16x4 tr_read(const LAS unsigned char* p) { return __builtin_bit_cast(s16x4, __builtin_amdgcn_ds_read_tr16_b64_v4i16((LAS v4i16_t*)p)); }
DI bf16x8 cat8(s16x4 lo, s16x4 hi) { return __builtin_shufflevector(lo, hi, 0, 1, 2, 3, 4, 5, 6, 7); }
DI int crow(int r, int h) { return (r & 3) + 8 * (r >> 2) + 4 * h; }
DI bf16x8 pack8(const f32x16& x, int s) {
    u32x4 p; p.x = pk2(x[8 * s], x[8 * s + 1]); p.y = pk2(x[8 * s + 2], x[8 * s + 3]); p.z = pk2(x[8 * s + 4], x[8 * s + 5]); p.w = pk2(x[8 * s + 6], x[8 * s + 7]);
    return __builtin_bit_cast(bf16x8, p);
}
DI f32x16 zero16() { f32x16 z;
#pragma unroll
    for (int i = 0; i < 16; ++i) z[i] = 0.f; return z; }

DI int prow(int n) { const int pn = n >> 8, co = n & 255; return 256 * pn + 128 * ((co >> 5) & 1) + 32 * (co >> 6) + (co & 31); }

DI void p0_transpose_item(const float* W, int ldw, int nblk, bf16* WT, int K, bool permute, LAS float* scr, int item, int lane) {
    const int kb = item / nblk, nb = item % nblk, k0 = 64 * kb, n0 = 32 * nb;
    float tv[32];
    { const float* wp = W + (size_t)(k0 + (lane >> 5)) * ldw + n0 + (lane & 31);
#pragma unroll
      for (int i = 0; i < 32; ++i) tv[i] = wp[(size_t)(2 * i) * ldw]; }
#pragma unroll
    for (int i = 0; i < 32; ++i) scr[(2 * i + (lane >> 5)) * 33 + (lane & 31)] = tv[i];
    LDS_WAIT();
    const int r0 = permute ? prow(n0) : n0;
    const int c = lane & 7;
#pragma unroll
    for (int j = 0; j < 4; ++j) { const int n = (lane >> 3) + 8 * j; const LAS float* s = scr + (8 * c) * 33 + n;
        u32x4 o; o.x = pk2(s[0 * 33], s[1 * 33]); o.y = pk2(s[2 * 33], s[3 * 33]); o.z = pk2(s[4 * 33], s[5 * 33]); o.w = pk2(s[6 * 33], s[7 * 33]);
        *(u32x4*)(WT + (size_t)(r0 + n) * K + k0 + 8 * c) = o; }
    LDS_WAIT();
}

DI void p0_weights(const Args& a, LAS unsigned char* lds, int l0, int l1, int wblk, int nblk) {
    const int tid = tid_opaque(), lane = tid & 63, wave = tid >> 6;
    const int gw = wblk * 8 + wave, NGW = nblk * 8;
    unsigned char* ws = a.ws;
    {
        LAS float* scr = (LAS float*)(lds + wave * 16384);
        constexpr int I_IN = 16 * 64, I_OUT = 16 * 32, I_1 = 16 * 128, I_2 = 64 * 32, I_L = I_IN + I_OUT + I_1 + I_2;
        for (int it = gw; it < (l1 - l0) * I_L; it += NGW) {
            const int l = l0 + it / I_L; int r = it % I_L;
            if (r < I_IN) { p0_transpose_item(a.in[8] + (size_t)l * D * PW, PW, 64, (bf16*)(ws + WS_WIN) + (size_t)l * NIN * D, D, true, scr, r, lane); continue; } r -= I_IN;
            if (r < I_OUT) { p0_transpose_item(a.in[9] + (size_t)l * D * D, D, 32, (bf16*)(ws + WS_WOUT) + (size_t)l * D * D, D, false, scr, r, lane); continue; } r -= I_OUT;
            if (r < I_1) { p0_transpose_item(a.in[16] + (size_t)l * D * FF, FF, 128, (bf16*)(ws + WS_W1) + (size_t)l * FF * D, D, false, scr, r, lane); continue; } r -= I_1;
            p0_transpose_item(a.in[17] + (size_t)l * FF * D, D, 32, (bf16*)(ws + WS_W2) + (size_t)l * D * FF, FF, false, scr, r, lane);
        }
    }
    __syncthreads();
    {
        LAS float* Wl = (LAS float*)lds;
        LAS float* tbl = (LAS float*)(lds + 16384);
        LAS float* CWl = (LAS float*)(lds + 20480);
        LAS float* Wk = (LAS float*)(lds + 40960);
        LAS bf16* outl = (LAS bf16*)(lds + 61440);
        for (int it = wblk; it < (l1 - l0) * 4 * 2 * 16; it += nblk) {
            const int ks = it & 15, trig = (it >> 4) & 1, g = (it >> 5) & 3, l = l0 + (it >> 7);
            const float* Wf = a.in[15] + ((size_t)(l * 4 + g)) * 4096;
            for (int i = tid; i < 4096; i += 512) Wl[i] = Wf[i];
            if (tid < 64) { float sv, cv; sv = sinpif((float)tid * (1.0f / 32.0f)); cv = cospif((float)tid * (1.0f / 32.0f)); tbl[tid] = (trig ? sv : cv) * 0.125f; }
            const float* wsrc = a.in[8] + (size_t)l * D * PW + (size_t)(ks * 64) * PW + 2048 + 64 * g;
            for (int i = tid; i < 4096; i += 512) { const int kk = i >> 6, c = i & 63; Wk[kk * 65 + c] = wsrc[(size_t)kk * PW + c]; }
            __syncthreads();
            { const int d = tid & 63;
#pragma unroll 1
              for (int i = 0; i < 8; ++i) { const int c = (tid >> 6) + 8 * i; float s = 0.f;
#pragma unroll 8
                  for (int m = 0; m < 64; ++m) s += tbl[(c * m) & 63] * Wl[m * 64 + d];
                  CWl[c * 65 + d] = s; } }
            __syncthreads();
            { const int d = tid & 63;
#pragma unroll 1
              for (int i = 0; i < 8; ++i) { const int kk = (tid >> 6) + 8 * i; float s = 0.f;
#pragma unroll 8
                  for (int c = 0; c < 64; ++c) s += Wk[kk * 65 + c] * CWl[c * 65 + d];
                  outl[d * 64 + kk] = (bf16)(pk2(s, 0.f) & 0xffffu); } }
            __syncthreads();
            { const int d = tid >> 3, ch = tid & 7;
              const int row = 256 * (8 + trig) + 128 * (d >> 5) + 32 * g + (d & 31);
              const u32x4 v = *(const LAS u32x4*)(outl + d * 64 + ch * 8);
              *(u32x4*)((bf16*)(ws + WS_WIN) + (size_t)l * NIN * D + (size_t)row * D + ks * 64 + ch * 8) = v; }
            __syncthreads();
        }
    }
}

DI void p0_prep(const Args& a, LAS unsigned char* lds) {
    const int tid = tid_opaque(), lane = tid & 63, wave = tid >> 6, G = gridDim.x, bid = blockIdx.x;
    const int gw = bid * 8 + wave, NGW = G * 8;
    unsigned char* ws = a.ws;
    if (bid == 0) { unsigned* ctl = (unsigned*)(ws + WS_CTL); for (int i = tid; i < 16384; i += 512) ctl[i] = 0u; }
    { float* rss = (float*)(ws + WS_RSS); for (int i = bid * 512 + tid; i < 2 * DEPTH * M; i += G * 512) rss[i] = 0.f; }
    p0_weights(a, lds, 0, 1, bid, G);
    __syncthreads();
    {
        LAS float* sc = (LAS float*)lds;
        LAS float* red = (LAS float*)(lds + 81920);
        bool staged = false;
        for (int it = bid; it < DEPTH * 192; it += G) {
            if (!staged) {
                for (int i = tid; i < 17 * 1024; i += 512) { const float v = (i < 16 * 1024) ? a.in[1][i] : a.in[3][i - 16 * 1024]; sc[(i & 1023) * 20 + (i >> 10)] = v / (1.f + __expf(-v)); }
                staged = true; __syncthreads();
            }
            const int l = it / 192, cb = it % 192, col = tid & 31, kg = tid >> 5, n = cb * 32 + col;
            const float* wp = a.in[4] + (size_t)l * D * 6144 + (size_t)(kg * 64) * 6144 + n;
            float acc[17];
#pragma unroll
            for (int r = 0; r < 17; ++r) acc[r] = 0.f;
#pragma unroll 1
            for (int kk0 = 0; kk0 < 64; kk0 += 16) { float wv[16];
#pragma unroll
                for (int u = 0; u < 16; ++u) wv[u] = wp[(size_t)(kk0 + u) * 6144];
#pragma unroll
                for (int u = 0; u < 16; ++u) { const LAS f32x4* sp = (const LAS f32x4*)(sc + (kg * 64 + kk0 + u) * 20);
                    const f32x4 s0 = sp[0], s1 = sp[1], s2 = sp[2], s3 = sp[3]; const float s4 = sc[(kg * 64 + kk0 + u) * 20 + 16];
                    acc[0] += s0.x * wv[u]; acc[1] += s0.y * wv[u]; acc[2] += s0.z * wv[u]; acc[3] += s0.w * wv[u];
                    acc[4] += s1.x * wv[u]; acc[5] += s1.y * wv[u]; acc[6] += s1.z * wv[u]; acc[7] += s1.w * wv[u];
                    acc[8] += s2.x * wv[u]; acc[9] += s2.y * wv[u]; acc[10] += s2.z * wv[u]; acc[11] += s2.w * wv[u];
                    acc[12] += s3.x * wv[u]; acc[13] += s3.y * wv[u]; acc[14] += s3.z * wv[u]; acc[15] += s3.w * wv[u];
                    acc[16] += s4 * wv[u]; } }
#pragma unroll
            for (int r = 0; r < 17; ++r) red[(kg * 17 + r) * 32 + col] = acc[r];
            __syncthreads();
            for (int o = tid; o < 17 * 32; o += 512) { const int r = o >> 5, cc = o & 31; float sm = a.in[5][l * 6144 + cb * 32 + cc];
#pragma unroll
                for (int k16 = 0; k16 < 16; ++k16) sm += red[(k16 * 17 + r) * 32 + cc];
                ((float*)(ws + WS_MOD))[((size_t)l * 17 + r) * 6144 + cb * 32 + cc] = sm; }
            __syncthreads();
        }
    }
    {
        const int gt = bid * 512 + tid, NT = G * 512;
        LAS f32x2_t* ctab = (LAS f32x2_t*)lds;
        __syncthreads();
        for (int r = tid; r < 2048; r += 512) { const float ang = (float)r * (1.0f / 1024.0f); ctab[r] = (f32x2_t){cospif(ang) * 0.02209708691207961f, sinpif(ang) * 0.02209708691207961f}; }
        __syncthreads();
        bf16* Dl = (bf16*)(ws + WS_DFTL);
        for (int idx = gt; idx < 2048 * 512; idx += NT) { const int k = idx >> 9, kk0 = (idx & 511) * 8; unsigned w[4];
#pragma unroll
            for (int e = 0; e < 8; e += 2) { float v[2];
#pragma unroll
                for (int q = 0; q < 2; ++q) { const int kk = kk0 + e + q, li = kk & 2047, tr = kk >> 11; const f32x2_t cs = ctab[(k * li) & 2047]; v[q] = tr ? -cs.y : cs.x; }
                w[e >> 1] = pk2(v[0], v[1]); }
            *(u32x4*)(Dl + (size_t)k * 4096 + kk0) = (u32x4){w[0], w[1], w[2], w[3]}; }
        bf16* Dc = (bf16*)(ws + WS_DFTC);
        for (int idx = gt; idx < 256 * 64; idx += NT) { const int k = idx >> 6, kk0 = (idx & 63) * 8; unsigned w[4];
#pragma unroll
            for (int e = 0; e < 8; e += 2) { float v[2];
#pragma unroll
                for (int q = 0; q < 2; ++q) { const int kk = kk0 + e + q, li = kk & 255, tr = kk >> 8; const f32x2_t cs = ctab[((k * li) & 255) * 8]; v[q] = (tr ? -cs.y : cs.x) * 2.8284271247461903f; }
                w[e >> 1] = pk2(v[0], v[1]); }
            *(u32x4*)(Dc + (size_t)k * 512 + kk0) = (u32x4){w[0], w[1], w[2], w[3]}; }
        __syncthreads();
        float2* axt = (float2*)(ws + WS_AXT); float2* rt = (float2*)(ws + WS_RT);
        for (int idx = gt; idx < 64 * 16; idx += NT) { const int pos = idx >> 4, i = idx & 15; const float fr = exp2f(-(float)i * (13.287712379549449f / 16.0f)); const float ang = (float)pos * fr; float sv, cv; sv = sinpif(ang * 0.3183098861837907f); cv = cospif(ang * 0.3183098861837907f); axt[idx] = make_float2(cv, sv); }
        for (int idx = gt; idx < 2048 * 32; idx += NT) { const int pos = idx >> 5, i = idx & 31; const float fr = exp2f(-(float)i * (13.287712379549449f / 32.0f)); const float ang = (float)pos * fr; float sv, cv; sv = sinpif(ang * 0.3183098861837907f); cv = cospif(ang * 0.3183098861837907f); rt[idx] = make_float2(cv, sv); }
    }
}


DI void p0_bias(const Args& a, LAS unsigned char* lds, int l0, int l1, int wblk, int nblk) {
    const int tid = tid_opaque(), lane = tid & 63, wave = tid >> 6;
    const int gw = wblk * 8 + wave, NGW = nblk * 8;
    unsigned char* ws = a.ws;
    const float* modb = (const float*)(ws + WS_MOD);
    {
        float* b1 = (float*)(ws + WS_BIAS); float* b2 = b1 + (size_t)DEPTH * 17 * NIN;
        LAS float* shl = (LAS float*)lds;
#pragma unroll 1
        for (int g8 = 2 * l0; g8 < 2 * l1; ++g8) {
            const int l = g8 >> 1; const bool isw1 = g8 & 1; const int N = isw1 ? FF : NIN;
            __syncthreads();
            for (int i = tid; i < 17 * 1024; i += 512) shl[i] = modb[(size_t)l * 17 * 6144 + (size_t)(i >> 10) * 6144 + (isw1 ? 3 : 0) * 1024 + (i & 1023)];
            __syncthreads();
            const bf16* wbase = isw1 ? (const bf16*)(ws + WS_W1) + (size_t)l * FF * D : (const bf16*)(ws + WS_WIN) + (size_t)l * NIN * D;
#pragma unroll 1
            for (int nn = gw; nn < N; nn += NGW) {
                const bf16* wrow = wbase + (size_t)nn * D + lane * 4;
                const u32x2 w0 = *(const u32x2*)(wrow), w1 = *(const u32x2*)(wrow + 256), w2 = *(const u32x2*)(wrow + 512), w3 = *(const u32x2*)(wrow + 768);
                float res = 0.f;
                int ln = lane; asm volatile("" : "+v"(ln));
#pragma unroll 2
                for (int r = 0; r < 17; ++r) { const LAS f32x4* sp = (const LAS f32x4*)(shl + r * 1024 + ln * 4); const f32x4 s0 = sp[0], s1 = sp[64], s2 = sp[128], s3 = sp[192];
                    float d = bflo(w0.x) * s0.x + bfhi(w0.x) * s0.y + bflo(w0.y) * s0.z + bfhi(w0.y) * s0.w + bflo(w1.x) * s1.x + bfhi(w1.x) * s1.y + bflo(w1.y) * s1.z + bfhi(w1.y) * s1.w
                            + bflo(w2.x) * s2.x + bfhi(w2.x) * s2.y + bflo(w2.y) * s2.z + bfhi(w2.y) * s2.w + bflo(w3.x) * s3.x + bfhi(w3.x) * s3.y + bflo(w3.y) * s3.z + bfhi(w3.y) * s3.w;
                    d = wave_sum(d); if (lane == r) res = d; }
                if (lane < 17) { if (isw1) b2[((size_t)l * 17 + lane) * FF + nn] = res; else b1[((size_t)l * 17 + lane) * NIN + nn] = res; }
            }
        }
    }
    __syncthreads();
}

DI void p0b_prep(const Args& a, LAS unsigned char* lds) {
    const int tid = tid_opaque(), lane = tid & 63, wave = tid >> 6, G = gridDim.x, bid = blockIdx.x;
    const int gw = bid * 8 + wave, NGW = G * 8;
    unsigned char* ws = a.ws;
    const float* modb = (const float*)(ws + WS_MOD);
    {
        float* gs = (float*)(ws + WS_GS);
        for (int idx = bid * 512 + tid; idx < DEPTH * 2 * 17 * 1024; idx += G * 512) { const int col = idx & 1023, rr = idx >> 10, r = rr % 17, lw = rr / 17, which = lw & 1, l = lw >> 1;
            const float g = (which ? a.in[7] : a.in[6])[l * D + col]; const float sc = modb[((size_t)l * 17 + r) * 6144 + (which ? 4 : 1) * 1024 + col]; gs[idx] = g * (1.f + sc); }
    }
    p0_bias(a, lds, 0, 1, bid, G);
    {
        const float* g = a.in[6]; bf16* A = (bf16*)(ws + WS_A); float* rss = (float*)(ws + WS_RSS);
        for (int r = gw; r < M; r += NGW) {
            const bool lat = r < NLAT; const float* xr = lat ? a.in[0] + (size_t)r * D : a.in[2] + (size_t)(r - NLAT) * D; const int bi = lat ? (r >> 11) : 16;
            const float* mp = modb + (size_t)bi * 6144 + 1024;
            f32x4 v[4]; float s = 0.f;
#pragma unroll
            for (int j = 0; j < 4; ++j) { v[j] = ((const f32x4*)xr)[lane + 64 * j]; s += (v[j].x * v[j].x + v[j].y * v[j].y) + (v[j].z * v[j].z + v[j].w * v[j].w); }
            s = wave_sum(s); if (lane == 0) rss[r] = s;
#pragma unroll
            for (int j = 0; j < 4; ++j) { const f32x4 gv = ((const f32x4*)g)[lane + 64 * j], sc = ((const f32x4*)mp)[lane + 64 * j]; const f32x4 y = v[j] * gv * (sc + 1.0f);
                ((u32x2*)(A + (size_t)r * D))[lane + 64 * j] = (u32x2){pk2(y.x, y.y), pk2(y.z, y.w)}; }
        }
    }
}

DI void norm_phase(const float* xl, const float* xc, const float* g, const float* mod, int shift_i, int scale_i, bf16* A, int rows) {
    const int tid = tid_opaque(), lane = tid & 63, gw = blockIdx.x * 8 + (tid >> 6), NGW = gridDim.x * 8;
    for (int r = gw; r < rows; r += NGW) {
        const bool lat = r < NLAT; const float* xr = lat ? xl + (size_t)r * D : xc + (size_t)(r - NLAT) * D; const int bi = lat ? (r >> 11) : 16;
        const float* mp = mod + (size_t)bi * 6144;
        f32x4 v[4]; float s = 0.f;
#pragma unroll
        for (int j = 0; j < 4; ++j) { v[j] = ((const f32x4*)xr)[lane + 64 * j]; s += (v[j].x * v[j].x + v[j].y * v[j].y) + (v[j].z * v[j].z + v[j].w * v[j].w); }
        const float rs = 1.0f / sqrtf(wave_sum(s) * (1.0f / D) + 1e-6f);
#pragma unroll
        for (int j = 0; j < 4; ++j) {
            const f32x4 gv = ((const f32x4*)g)[lane + 64 * j], sh = ((const f32x4*)(mp + shift_i * 1024))[lane + 64 * j], sc = ((const f32x4*)(mp + scale_i * 1024))[lane + 64 * j];
            const f32x4 y = v[j] * rs * gv * (sc + 1.0f) + sh;
            ((u32x2*)(A + (size_t)r * D))[lane + 64 * j] = (u32x2){pk2(y.x, y.y), pk2(y.z, y.w)};
        }
    }
}

struct OneUnit {
    pg8::Unit u;
    DI bool next(int i, pg8::Unit& o) const { if (i != 0) return false; o = u; return true; }
    DI void a_ready(const pg8::Unit&) const {}
    DI void done(const pg8::Unit&) const {}
};

struct EpiWin {
    static constexpr bool PERM = false, AFTER_DRAIN = false;
    unsigned char* ws_; const AS4 Args* ap_; int l_;
    DI void operator()(const f32x4 (&acc)[2][2][4][2], const pg8::Unit& u, int wr, int wc, int fr, int fq) const {
        asm volatile("" : "+v"(fr), "+v"(fq));
        const int pn = u.pn;
        unsigned char* ws = ws_; const AS4 Args* ap = ap_; int l = l_;
        asm volatile("" : "+s"(ws), "+s"(ap), "+s"(l));
        bf16* P = (bf16*)(ws + WS_P); bf16* TTl = (bf16*)(ws + WS_TTL); bf16* TTc = (bf16*)(ws + WS_TTC);
        const float* qg = ap->in[10] + l * 64; const float* kg = ap->in[11] + l * 64;
        const float2* axt = (const float2*)(ws + WS_AXT); const float2* rt = (const float2*)(ws + WS_RT);
        const float* rss = (const float*)(ws + WS_RSS) + (size_t)(2 * l) * M;
        const float* bias = (const float*)(ws + WS_BIAS) + (size_t)l * 17 * NIN;
        int kind; float scl = 1.f; const float* gptr = qg;
        if (pn < 2) { kind = 1; scl = 0.125f * LOG2E; }
        else if (pn == 2) { if (wc < 2) { kind = 1; gptr = kg; } else kind = 0; }
        else if (pn == 3) kind = 2;
        else if (pn == 4) { kind = 2; scl = 0.125f; }
        else if (pn == 5) kind = 0;
        else if (pn < 8) kind = 3;
        else kind = 4;
        const bool lat = u.pm < (NLAT / 256);
        f32x4 bvv[2][2];
        { const float* bp = bias + (size_t)(lat ? ((u.pm * 256) >> 11) : 16) * NIN + 256 * pn + 32 * wc + 4 * fq;
#pragma unroll
          for (int bj = 0; bj < 2; ++bj)
#pragma unroll
          for (int n = 0; n < 2; ++n) bvv[bj][n] = *(const f32x4*)(bp + 128 * bj + 16 * n); }
#pragma unroll
        for (int ai = 0; ai < 2; ++ai)
#pragma unroll
        for (int m = 0; m < 4; ++m) {
            const int row = u.pm * 256 + ai * 128 + wr * 64 + m * 16 + fr;
            const int t = lat ? (row & 2047) : (row & 255);
            float v[2][2][4];
            const float rsd = 1.0f / sqrtf(rss[row] * (1.0f / 1024.0f) + 1e-6f);
#pragma unroll
            for (int bj = 0; bj < 2; ++bj)
#pragma unroll
            for (int n = 0; n < 2; ++n) { const f32x4 bv = bvv[bj][n];
#pragma unroll
                for (int e = 0; e < 4; ++e) v[bj][n][e] = acc[ai][bj][m][n][e] * rsd + bv[e]; }
            if (kind == 1) {
                float ss = 0.f;
#pragma unroll
                for (int bj = 0; bj < 2; ++bj)
#pragma unroll
                for (int n = 0; n < 2; ++n)
#pragma unroll
                for (int e = 0; e < 4; ++e) ss += v[bj][n][e] * v[bj][n][e];
                ss += __shfl_xor(ss, 16); ss += __shfl_xor(ss, 32);
                const float rs = 1.0f / sqrtf(ss * (1.0f / 64.0f) + 1e-6f);
#pragma unroll
                for (int bj = 0; bj < 2; ++bj)
#pragma unroll
                for (int n = 0; n < 2; ++n) { const f32x4 gv = *(const f32x4*)(gptr + 32 * bj + 16 * n + 4 * fq);
#pragma unroll
                    for (int e = 0; e < 4; ++e) v[bj][n][e] *= rs * gv[e]; }
                if (lat) {
#pragma unroll
                    for (int bj = 0; bj < 2; ++bj) { const int pos = bj ? (t & 63) : (t >> 6);
#pragma unroll
                        for (int e = 0; e < 4; ++e) { const float2 cs = axt[pos * 16 + 4 * fq + e]; const float x1 = v[bj][0][e], x2 = v[bj][1][e];
                            v[bj][0][e] = x1 * cs.x - x2 * cs.y; v[bj][1][e] = x2 * cs.x + x1 * cs.y; } }
                }
            } else if (kind == 2) {
                if (lat) {
#pragma unroll
                    for (int n = 0; n < 2; ++n)
#pragma unroll
                    for (int e = 0; e < 4; ++e) { const float2 cs = rt[t * 32 + 16 * n + 4 * fq + e]; const float x1 = v[0][n][e], x2 = v[1][n][e];
                        v[0][n][e] = x1 * cs.x - x2 * cs.y; v[1][n][e] = x2 * cs.x + x1 * cs.y; }
                }
            } else if (kind == 3) {
#pragma unroll
                for (int bj = 0; bj < 2; ++bj)
#pragma unroll
                for (int n = 0; n < 2; ++n)
#pragma unroll
                for (int e = 0; e < 4; ++e) { const float x = v[bj][n][e]; v[bj][n][e] = x / (1.0f + __expf(-x)); }
            }
            if (kind != 4) {
                bf16* rp = P + (size_t)row * PC + 256 * pn + 64 * wc + 4 * fq;
#pragma unroll
                for (int bj = 0; bj < 2; ++bj)
#pragma unroll
                for (int n = 0; n < 2; ++n)
                    *(u32x2*)(rp + 32 * bj + 16 * n) = (u32x2){pk2(v[bj][n][0] * scl, v[bj][n][1] * scl), pk2(v[bj][n][2] * scl, v[bj][n][3] * scl)};
            } else {
                const int trig = pn - 8;
                bf16* tp = lat ? TTl + ((size_t)((row >> 11) * 256)) * 4096 + trig * 2048 + t : TTc + ((size_t)(((row - NLAT) >> 8) * 256)) * 512 + trig * 256 + t;
                const size_t pitch = lat ? 4096 : 512;
#pragma unroll
                for (int bj = 0; bj < 2; ++bj)
#pragma unroll
                for (int n = 0; n < 2; ++n)
#pragma unroll
                for (int e = 0; e < 4; ++e) { const int nch = 64 * wc + 32 * bj + 16 * n + 4 * fq + e; tp[(size_t)nch * pitch] = (bf16)(pk2(v[bj][n][e], 0.f) & 0xffffu); }
            }
        }
    }
};

template <bool XS> struct EpiRes {
    static constexpr bool PERM = false, AFTER_DRAIN = false;
    unsigned char* ws_; const AS4 Args* ap_; int l_; int ff2_;
    DI void operator()(const f32x4 (&acc)[2][2][4][2], const pg8::Unit& u, int wr, int wc, int fr, int fq) const {
        asm volatile("" : "+v"(fr), "+v"(fq));
        const bool lat = u.pm < (NLAT / 256);
        unsigned char* ws = ws_; const AS4 Args* ap = ap_; int l = l_, ff2 = ff2_;
        asm volatile("" : "+s"(ws), "+s"(ap), "+s"(l), "+s"(ff2));
        float* out_lat = ap->out; float* out_ctx = (float*)(ws + WS_XC);
        const float* base_lat = (l == 0 && !ff2) ? ap->in[0] : out_lat; const float* base_ctx = (l == 0 && !ff2) ? ap->in[2] : out_ctx;
        const float* gate = (const float*)(ws + WS_MOD) + (size_t)l * 17 * 6144 + (ff2 ? 5 : 2) * 1024;
        bf16* xs = (bf16*)(ws + WS_A);
        const float* gs = (const float*)(ws + WS_GS) + (size_t)((ff2 ? (l + 1) * 2 : l * 2 + 1) * 17) * 1024;
        float* rss = (float*)(ws + WS_RSS) + (size_t)(ff2 ? 2 * l + 2 : 2 * l + 1) * M;
        const int bi = lat ? ((u.pm * 256) >> 11) : 16;
        f32x4 gvv[2][2], gsvv[2][2];
#pragma unroll
        for (int bj = 0; bj < 2; ++bj)
#pragma unroll
        for (int n = 0; n < 2; ++n) { const int col = u.pn * 256 + bj * 128 + wc * 32 + n * 16 + 4 * fq;
            gvv[bj][n] = *(const f32x4*)(gate + (size_t)bi * 6144 + col); gsvv[bj][n] = XS ? *(const f32x4*)(gs + bi * 1024 + col) : (f32x4){0.f, 0.f, 0.f, 0.f}; }
        const int row00 = u.pm * 256 + wr * 64 + fr, colb = u.pn * 256 + wc * 32 + 4 * fq;
        const float* bp0 = lat ? base_lat + (size_t)row00 * D + colb : base_ctx + (size_t)(row00 - NLAT) * D + colb;
#pragma unroll
        for (int am = 0; am < 4; ++am) { const int ai = am >> 1;
        f32x4 bvv[4][2][2];
#pragma unroll
        for (int m = (am & 1) * 2; m < (am & 1) * 2 + 2; ++m)
#pragma unroll
        for (int bj = 0; bj < 2; ++bj)
#pragma unroll
        for (int n = 0; n < 2; ++n) bvv[m][bj][n] = *(const f32x4*)(bp0 + (size_t)(ai * 128 + m * 16) * D + bj * 128 + n * 16);
#pragma unroll
        for (int m = (am & 1) * 2; m < (am & 1) * 2 + 2; ++m) {
            const int row = u.pm * 256 + ai * 128 + wr * 64 + m * 16 + fr;
            float* op = lat ? out_lat + (size_t)row * D : out_ctx + (size_t)(row - NLAT) * D;
            float ssq = 0.f;
#pragma unroll
            for (int bj = 0; bj < 2; ++bj)
#pragma unroll
            for (int n = 0; n < 2; ++n) { const int col = u.pn * 256 + bj * 128 + wc * 32 + n * 16 + 4 * fq;
                const f32x4 bv = bvv[m][bj][n], gv = gvv[bj][n];
                const f32x4 o = bv + gv * acc[ai][bj][m][n];
                *(f32x4*)(op + col) = o;
                if (XS) { const f32x4 gsv = gsvv[bj][n]; const f32x4 y = o * gsv;
                    ssq += (o.x * o.x + o.y * o.y) + (o.z * o.z + o.w * o.w);
                    *(u32x2*)(xs + (size_t)row * D + col) = (u32x2){pk2(y.x, y.y), pk2(y.z, y.w)}; } }
            if (XS) { ssq += __shfl_xor(ssq, 16); ssq += __shfl_xor(ssq, 32);
                if (fq == 0) (void)__hip_atomic_fetch_add(rss + row, ssq, __ATOMIC_RELAXED, __HIP_MEMORY_SCOPE_AGENT); }
        }
        }
    }
};

template <int ACT  , bool DFT, bool NORM  > struct EpiB16 {
    static constexpr bool PERM = true, AFTER_DRAIN = false;
    unsigned char* ws_; size_t o_off; int ldc; int rows_per_b; int row_base; int col_base; int l_;
    DI void operator()(const f32x4 (&acc)[2][2][4][2], const pg8::Unit& u, int wr, int wc, int fr, int fq) const {
        asm volatile("" : "+v"(fr), "+v"(fq));
        unsigned char* ws = ws_; int l = l_; asm volatile("" : "+s"(ws), "+s"(l));
        bf16* O = (bf16*)(ws + o_off);
        const float* rss = (const float*)(ws + WS_RSS) + (size_t)(2 * l + 1) * M;
        const float* bias = (const float*)(ws + WS_BIAS) + (size_t)DEPTH * 17 * NIN + (size_t)l * 17 * FF;
        const int row0 = (DFT ? row_base + u.pn * rows_per_b + u.pm * 256 : u.pm * 256) + wr * 64 + fr;
        const int col0 = (DFT ? col_base : u.pn * 256) + wc * 32 + 8 * fq;
        f32x4 bvv[2][2];
        if (NORM) { const float* bp = bias + (size_t)(u.pm < (NLAT / 256) ? ((u.pm * 256) >> 11) : 16) * ldc + col0;
#pragma unroll
            for (int bj = 0; bj < 2; ++bj) { bvv[bj][0] = *(const f32x4*)(bp + bj * 128); bvv[bj][1] = *(const f32x4*)(bp + bj * 128 + 4); } }
#pragma unroll
        for (int ai = 0; ai < 2; ++ai)
#pragma unroll
        for (int m = 0; m < 4; ++m) { const int row = row0 + ai * 128 + m * 16; bf16* rowp = O + (size_t)row * ldc + col0;
            float rsd = 1.f;
            if (NORM) rsd = 1.0f / sqrtf(rss[row] * (1.0f / 1024.0f) + 1e-6f);
#pragma unroll
            for (int bj = 0; bj < 2; ++bj) { f32x4 v0 = acc[ai][bj][m][0], v1 = acc[ai][bj][m][1];
                if (NORM) { v0 = v0 * rsd + bvv[bj][0]; v1 = v1 * rsd + bvv[bj][1]; }
                if (ACT == 1) {
#pragma unroll
                    for (int e = 0; e < 4; ++e) { const float a0 = fmaxf(v0[e], 0.f), a1 = fmaxf(v1[e], 0.f); v0[e] = a0 * a0; v1[e] = a1 * a1; } }
                u32x4 w; w.x = pk2(v0[0], v0[1]); w.y = pk2(v0[2], v0[3]); w.z = pk2(v1[0], v1[1]); w.w = pk2(v1[2], v1[3]);
                *(u32x4*)(rowp + bj * 128) = w; } }
    }
};

constexpr int TROW = 144;
DI void attn_item(LAS unsigned char* lds, const bf16* P, bf16* Y, const float* sink, int item, bool ctxq) {
    const int tid = tid_opaque(), lane = tid & 63, w = tid >> 6, h = lane >> 5, r32 = lane & 31;
    int b, n, kvh, hp, qrow0, ulo, uhi;
    if (!ctxq) { hp = item & 1; kvh = (item >> 1) & 1; n = (item >> 2) & 15; b = item >> 6; qrow0 = b * SEQ + n * 128; ulo = (n == 0) ? 2 : 0; uhi = (n == 15) ? 4 : 6; }
    else { hp = item & 1; kvh = (item >> 1) & 1; n = (item >> 2) & 1; b = item >> 3; qrow0 = NLAT + b * LCTX + n * 128; ulo = 0; uhi = 0; }
    const int cnt = 4 + (uhi - ulo);
    const int hq = 4 * kvh + 2 * hp + (w >> 2), iloc = 32 * (w & 3) + r32, qrow = qrow0 + iloc;
    bf16x8 bq[4];
#pragma unroll
    for (int s = 0; s < 4; ++s) bq[s] = *(const bf16x8*)(P + (size_t)qrow * PC + C_AQ + hq * 64 + 16 * s + 8 * h);
    float m_run = sink[hq] * LOG2E, l_run = 1.0f;
    f32x16 O0 = zero16(), O1 = zero16();
    const int lkey = tid >> 3, lch = tid & 7;
    const int ctxrow0 = NLAT + b * LCTX;
#define ATT_TILE_ROW(q_) ((q_) < 4 ? ctxrow0 + 64 * (q_) : b * SEQ + (n - 1 + (((q_) - 4 + ulo) >> 1)) * 128 + 64 * (((q_) - 4 + ulo) & 1))
    u32x4 kreg, vreg;
    { const int kr = ATT_TILE_ROW(0) + lkey; const bf16* gp = P + (size_t)kr * PC + kvh * 64 + lch * 8; kreg = *(const u32x4*)(gp + C_AK); vreg = *(const u32x4*)(gp + C_AV); }
    *(LAS u32x4*)(lds + lkey * TROW + lch * 16) = kreg; *(LAS u32x4*)(lds + 18432 + lkey * TROW + lch * 16) = vreg;
    __syncthreads();
    const int i16 = lane & 15, tq = i16 >> 2, tp = i16 & 3, blk = (lane >> 4) & 1;
    for (int q = 0; q < cnt; ++q) {
        const int buf = q & 1;
        if (q + 1 < cnt) { const int kr = ATT_TILE_ROW(q + 1) + lkey; const bf16* gp = P + (size_t)kr * PC + kvh * 64 + lch * 8; kreg = *(const u32x4*)(gp + C_AK); vreg = *(const u32x4*)(gp + C_AV); }
        const LAS unsigned char* Kb = lds + buf * 9216; const LAS unsigned char* Vb = lds + 18432 + buf * 9216;
        f32x16 S0 = zero16(), S1 = zero16();
        bf16x8 kf[8];
#pragma unroll
        for (int s = 0; s < 4; ++s) { kf[2 * s] = *(const LAS bf16x8*)(Kb + r32 * TROW + (16 * s + 8 * h) * 2); kf[2 * s + 1] = *(const LAS bf16x8*)(Kb + (32 + r32) * TROW + (16 * s + 8 * h) * 2); }
        s16x4 tv[2][8];
#pragma unroll
        for (int dvt = 0; dvt < 2; ++dvt) { const LAS unsigned char* vb = Vb + (4 * h + tq) * TROW + (32 * dvt + 16 * blk + 4 * tp) * 2;
#pragma unroll
            for (int i = 0; i < 8; ++i) tv[dvt][i] = tr_read(vb + 8 * i * TROW); }
        __builtin_amdgcn_sched_barrier(0);
#pragma unroll
        for (int s = 0; s < 4; ++s) { S0 = MFMA32(kf[2 * s], bq[s], S0); S1 = MFMA32(kf[2 * s + 1], bq[s], S1); }
        int mk = 0, joff = 0;
        if (q >= 4) { const int u = q - 4 + ulo; mk = (u >> 1) == 0 ? 1 : ((u >> 1) == 2 ? 2 : 0); joff = 64 * (u & 1); }
        if (mk) {
#pragma unroll
            for (int r = 0; r < 16; ++r) { const int j0 = joff + crow(r, h), j1 = j0 + 32;
                const bool v0 = (mk == 1) ? (j0 >= iloc) : (j0 <= iloc), v1 = (mk == 1) ? (j1 >= iloc) : (j1 <= iloc);
                S0[r] = v0 ? S0[r] : -1e30f; S1[r] = v1 ? S1[r] : -1e30f; }
        }
        float mx = fmaxf(S0[0], S1[0]);
#pragma unroll
        for (int r = 1; r < 16; ++r) mx = fmaxf(mx, fmaxf(S0[r], S1[r]));
        mx = fmaxf(mx, __shfl_xor(mx, 32));
        const float mnew = fmaxf(m_run, mx), alpha = ex2(m_run - mnew); m_run = mnew;
        float rs = 0.f;
#pragma unroll
        for (int r = 0; r < 16; ++r) { S0[r] = ex2(S0[r] - mnew); S1[r] = ex2(S1[r] - mnew); rs += S0[r] + S1[r]; }
        rs += __shfl_xor(rs, 32);
        l_run = l_run * alpha + rs;
#pragma unroll
        for (int r = 0; r < 16; ++r) { O0[r] *= alpha; O1[r] *= alpha; }
        const bf16x8 p00 = pack8(S0, 0), p01 = pack8(S0, 1), p10 = pack8(S1, 0), p11 = pack8(S1, 1);
#pragma unroll
        for (int dvt = 0; dvt < 2; ++dvt) {
            const bf16x8 a00 = cat8(tv[dvt][0], tv[dvt][1]);
            const bf16x8 a01 = cat8(tv[dvt][2], tv[dvt][3]);
            const bf16x8 a10 = cat8(tv[dvt][4], tv[dvt][5]);
            const bf16x8 a11 = cat8(tv[dvt][6], tv[dvt][7]);
            if (dvt == 0) { O0 = MFMA32(a00, p00, O0); O0 = MFMA32(a01, p01, O0); O0 = MFMA32(a10, p10, O0); O0 = MFMA32(a11, p11, O0); }
            else          { O1 = MFMA32(a00, p00, O1); O1 = MFMA32(a01, p01, O1); O1 = MFMA32(a10, p10, O1); O1 = MFMA32(a11, p11, O1); }
        }
        __builtin_amdgcn_sched_barrier(0);
        if (q + 1 < cnt) { *(LAS u32x4*)(lds + (buf ^ 1) * 9216 + lkey * TROW + lch * 16) = kreg; *(LAS u32x4*)(lds + 18432 + (buf ^ 1) * 9216 + lkey * TROW + lch * 16) = vreg; }
        __syncthreads();
    }
#undef ATT_TILE_ROW
    const float inv = 1.0f / l_run;
    bf16* yp = Y + (size_t)qrow * D + hq * 64 + 4 * h;
#pragma unroll
    for (int g4 = 0; g4 < 4; ++g4) {
        *(u32x2*)(yp + 8 * g4) = (u32x2){pk2(O0[4 * g4] * inv, O0[4 * g4 + 1] * inv), pk2(O0[4 * g4 + 2] * inv, O0[4 * g4 + 3] * inv)};
        *(u32x2*)(yp + 32 + 8 * g4) = (u32x2){pk2(O1[4 * g4] * inv, O1[4 * g4 + 1] * inv), pk2(O1[4 * g4 + 2] * inv, O1[4 * g4 + 3] * inv)};
    }
}

DI float log2gamma(const float* logit, int dir, int hd) { const float x = logit[dir * 4 + hd]; return -log1pf(expf(-x)) * LOG2E; }
DI int chunk_row0(int b, int c) { return c < 2 ? NLAT + b * LCTX + 128 * c : b * SEQ + 128 * (c - 2); }
DI int ord_b(int c) { return c < 2 ? 1 - c : 19 - c; }

DI void load_tile128(LAS unsigned char* dst, const bf16* src  , int tid) {
#pragma unroll
    for (int i = 0; i < 2; ++i) { const int idx = tid + 512 * i, row = idx >> 3, ch = idx & 7;
        *(LAS u32x4*)(dst + row * TROW + ch * 16) = *(const u32x4*)(src + (size_t)row * PC + ch * 8); }
}

struct RsPre { u32x4 k0, k1, v0, v1; };
DI void ret_state_fetch(RsPre& r, const bf16* P, int item, int tid) {
    const int c = item % NCH, hd = (item / NCH) & 3, b = item / (NCH * 4);
    const bf16* src = P + (size_t)chunk_row0(b, c) * PC + hd * 64 + (size_t)(tid >> 3) * PC + (tid & 7) * 8;
    r.k0 = *(const u32x4*)(src + C_RK); r.k1 = *(const u32x4*)(src + (size_t)64 * PC + C_RK);
    r.v0 = *(const u32x4*)(src + C_RV); r.v1 = *(const u32x4*)(src + (size_t)64 * PC + C_RV);
}
DI void ret_state_item(LAS unsigned char* lds, const RsPre& pre, float* KV, const float* logit, int item) {
    const int tid = tid_opaque(), lane = tid & 63, w = tid >> 6, hh = lane >> 5, r32 = lane & 31;
    const int c = item % NCH, hd = (item / NCH) & 3, b = item / (NCH * 4);
    const int row0 = chunk_row0(b, c);
    LAS unsigned char* Kl = lds; LAS unsigned char* Vl = lds + 18432; LAS float* zl = (LAS float*)(lds + 36864);
    { const unsigned to = (tid >> 3) * TROW + (tid & 7) * 16;
      *(LAS u32x4*)(Kl + to) = pre.k0; *(LAS u32x4*)(Kl + 64 * TROW + to) = pre.k1; *(LAS u32x4*)(Vl + to) = pre.v0; *(LAS u32x4*)(Vl + 64 * TROW + to) = pre.v1; }
    if (tid < 256) { const int dir = tid >> 7, j = tid & 127; const float lg = log2gamma(logit, dir, hd); zl[tid] = ex2((float)(dir ? j : 127 - j) * lg); }
    __syncthreads();
    const int dir = w >> 2, dvt = (w >> 1) & 1, dkt = w & 1;
    const int i16 = lane & 15, tq = i16 >> 2, tp = i16 & 3, blk = (lane >> 4) & 1;
    f32x16 acc = zero16();
    s16x4 tvv[8][2], tkk[8][2]; f32x4 zz[8][2];
#pragma unroll
    for (int s = 0; s < 8; ++s) {
        const LAS unsigned char* vb = Vl + (16 * s + 8 * hh + tq) * TROW + (32 * dvt + 16 * blk + 4 * tp) * 2;
        const LAS unsigned char* kb = Kl + (16 * s + 8 * hh + tq) * TROW + (32 * dkt + 16 * blk + 4 * tp) * 2;
        tvv[s][0] = tr_read(vb); tvv[s][1] = tr_read(vb + 4 * TROW); tkk[s][0] = tr_read(kb); tkk[s][1] = tr_read(kb + 4 * TROW);
        const LAS f32x4* zp = (const LAS f32x4*)(zl + dir * 128 + 16 * s + 8 * hh); zz[s][0] = zp[0]; zz[s][1] = zp[1];
    }
    __builtin_amdgcn_sched_barrier(0);
#pragma unroll
    for (int s = 0; s < 8; ++s) {
        const bf16x8 av = cat8(tvv[s][0], tvv[s][1]);
        const bf16x8 kr = cat8(tkk[s][0], tkk[s][1]);
        u32x4 kk; kk.x = pk2(bf2f(kr[0]) * zz[s][0].x, bf2f(kr[1]) * zz[s][0].y); kk.y = pk2(bf2f(kr[2]) * zz[s][0].z, bf2f(kr[3]) * zz[s][0].w);
        kk.z = pk2(bf2f(kr[4]) * zz[s][1].x, bf2f(kr[5]) * zz[s][1].y); kk.w = pk2(bf2f(kr[6]) * zz[s][1].z, bf2f(kr[7]) * zz[s][1].w);
        acc = MFMA32(av, __builtin_bit_cast(bf16x8, kk), acc);
    }
    float* op = KV + ((size_t)(((b * 4 + hd) * 2 + dir) * NCH + c)) * 4096 + 32 * dkt + r32;
#pragma unroll
    for (int r = 0; r < 16; ++r) op[(32 * dvt + crow(r, hh)) * 64] = acc[r];
    __syncthreads();
}

DI void ret_scan_item(const float* KV, bf16* SS, const float* logit, int item) {
    const int tid = tid_opaque();
    const int half = item & 1, dir = (item >> 1) & 1, hd = (item >> 2) & 3, b = item >> 4;
    const float G = ex2(128.0f * log2gamma(logit, dir, hd));
    const size_t base = (size_t)(((b * 4 + hd) * 2 + dir) * NCH) * 4096 + half * 2048 + tid * 4;
    f32x4 v[NCH];
#pragma unroll
    for (int c = 0; c < NCH; ++c) v[c] = *(const f32x4*)(KV + base + (size_t)c * 4096);
    f32x4 S = (f32x4){0.f, 0.f, 0.f, 0.f};
    if (dir == 0) {
#pragma unroll
        for (int c = 0; c < NCH; ++c) { *(u32x2*)(SS + base + (size_t)c * 4096) = (u32x2){pk2(S.x, S.y), pk2(S.z, S.w)}; S = S * G + v[c]; }
    } else {
#pragma unroll
        for (int o = 0; o < NCH; ++o) { const int c = (o < 2) ? 1 - o : 19 - o;
            *(u32x2*)(SS + base + (size_t)c * 4096) = (u32x2){pk2(S.x, S.y), pk2(S.z, S.w)}; S = S * G + v[c]; }
    }
}

struct RetPre { u32x4 q0, q1, k0, k1, v0, v1, s0, s1; };
DI void ret_out_fetch(RetPre& r, const bf16* P, const bf16* SS, int item, int tid) {
    const int c = item % NCH, hd = (item / NCH) & 3, b = item / (NCH * 4);
    const bf16* src = P + (size_t)chunk_row0(b, c) * PC + hd * 64 + (size_t)(tid >> 3) * PC + (tid & 7) * 8;
    r.q0 = *(const u32x4*)(src + C_RQ); r.q1 = *(const u32x4*)(src + (size_t)64 * PC + C_RQ);
    r.k0 = *(const u32x4*)(src + C_RK); r.k1 = *(const u32x4*)(src + (size_t)64 * PC + C_RK);
    r.v0 = *(const u32x4*)(src + C_RV); r.v1 = *(const u32x4*)(src + (size_t)64 * PC + C_RV);
    const bf16* sf = SS + ((size_t)(((b * 4 + hd) * 2 + 0) * NCH + c)) * 4096 + tid * 8;
    r.s0 = *(const u32x4*)sf; r.s1 = *(const u32x4*)(sf + (size_t)NCH * 4096);
}
DI void ret_out_item(LAS unsigned char* lds, const bf16* P, const RetPre& pre, bf16* Y, const float* logit, const float* gng, int item) {
    const int tid = tid_opaque(), lane = tid & 63, w = tid >> 6, hh = lane >> 5, r32 = lane & 31;
    const int c = item % NCH, hd = (item / NCH) & 3, b = item / (NCH * 4);
    const int row0 = chunk_row0(b, c);
    LAS unsigned char* Ql = lds; LAS unsigned char* Kl = lds + 18432; LAS unsigned char* Vl = lds + 36864; LAS unsigned char* St = lds + 55296; LAS float* X = (LAS float*)(lds + 73728);
    { const unsigned to = (tid >> 3) * TROW + (tid & 7) * 16;
      *(LAS u32x4*)(Ql + to) = pre.q0; *(LAS u32x4*)(Ql + 64 * TROW + to) = pre.q1;
      *(LAS u32x4*)(Kl + to) = pre.k0; *(LAS u32x4*)(Kl + 64 * TROW + to) = pre.k1;
      *(LAS u32x4*)(Vl + to) = pre.v0; *(LAS u32x4*)(Vl + 64 * TROW + to) = pre.v1;
      const int e = tid * 8, dv = e >> 6, dk = e & 63;
      *(LAS u32x4*)(St + dv * TROW + dk * 2) = pre.s0; *(LAS u32x4*)(St + 9216 + dv * TROW + dk * 2) = pre.s1; }
    __syncthreads();
    const int dir = w >> 2, rt = w & 3, iloc = 32 * rt + r32;
    const float lg = log2gamma(logit, dir, hd);
    const int i16 = lane & 15, tq = i16 >> 2, tp = i16 & 3, blk = (lane >> 4) & 1;
    u32x2 gwv[4][2];
    { const bf16* gp = P + (size_t)(row0 + iloc) * PC + (dir ? C_GB : C_GF) + hd * 64 + 4 * hh;
#pragma unroll
      for (int g4 = 0; g4 < 4; ++g4) { gwv[g4][0] = *(const u32x2*)(gp + 8 * g4); gwv[g4][1] = *(const u32x2*)(gp + 32 + 8 * g4); } }
    const float* gn = gng + hd * 64 + 4 * hh;
    bf16x8 bq[4];
#pragma unroll
    for (int s = 0; s < 4; ++s) bq[s] = *(const LAS bf16x8*)(Ql + iloc * TROW + (16 * s + 8 * hh) * 2);
    f32x16 O0 = zero16(), O1 = zero16();
    { bf16x8 sa[8];
#pragma unroll
      for (int s = 0; s < 4; ++s) { sa[2 * s] = *(const LAS bf16x8*)(St + dir * 9216 + r32 * TROW + (16 * s + 8 * hh) * 2); sa[2 * s + 1] = *(const LAS bf16x8*)(St + dir * 9216 + (32 + r32) * TROW + (16 * s + 8 * hh) * 2); }
      __builtin_amdgcn_sched_barrier(0);
#pragma unroll
      for (int s = 0; s < 4; ++s) { O0 = MFMA32(sa[2 * s], bq[s], O0); O1 = MFMA32(sa[2 * s + 1], bq[s], O1); } }
    { const float xi = ex2((float)(dir ? 128 - iloc : iloc + 1) * lg);
#pragma unroll
      for (int r = 0; r < 16; ++r) { O0[r] *= xi; O1[r] *= xi; } }
    const int jlo = dir ? rt : 0, jhi = dir ? 3 : rt;
    for (int jt = jlo; jt <= jhi; ++jt) {
        f32x16 S = zero16();
        bf16x8 kf[4]; s16x4 tv[2][4];
#pragma unroll
        for (int s = 0; s < 4; ++s) kf[s] = *(const LAS bf16x8*)(Kl + (32 * jt + r32) * TROW + (16 * s + 8 * hh) * 2);
#pragma unroll
        for (int dvt = 0; dvt < 2; ++dvt) { const LAS unsigned char* vb = Vl + (32 * jt + 4 * hh + tq) * TROW + (32 * dvt + 16 * blk + 4 * tp) * 2;
#pragma unroll
            for (int i = 0; i < 4; ++i) tv[dvt][i] = tr_read(vb + 8 * i * TROW); }
        __builtin_amdgcn_sched_barrier(0);
#pragma unroll
        for (int s = 0; s < 4; ++s) S = MFMA32(kf[s], bq[s], S);
#pragma unroll
        for (int r = 0; r < 16; ++r) { const int j = 32 * jt + crow(r, hh); const int dd = dir ? j - iloc : iloc - j; S[r] = dd >= 0 ? S[r] * ex2((float)dd * lg) : 0.f; }
        const bf16x8 p0 = pack8(S, 0), p1 = pack8(S, 1);
#pragma unroll
        for (int dvt = 0; dvt < 2; ++dvt) {
            const bf16x8 a0 = cat8(tv[dvt][0], tv[dvt][1]);
            const bf16x8 a1 = cat8(tv[dvt][2], tv[dvt][3]);
            if (dvt == 0) { O0 = MFMA32(a0, p0, O0); O0 = MFMA32(a1, p1, O0); } else { O1 = MFMA32(a0, p0, O1); O1 = MFMA32(a1, p1, O1); }
        }
    }
    float sm = 0.f;
#pragma unroll
    for (int r = 0; r < 16; ++r) sm += O0[r] + O1[r];
    sm += __shfl_xor(sm, 32);
    const float mu = sm * (1.0f / 64.0f);
    float sq = 0.f;
#pragma unroll
    for (int r = 0; r < 16; ++r) { const float d0 = O0[r] - mu, d1 = O1[r] - mu; sq += d0 * d0 + d1 * d1; }
    sq += __shfl_xor(sq, 32);
    const float rstd = 1.0f / sqrtf(sq * (1.0f / 64.0f) + 1e-6f);
#pragma unroll
    for (int g4 = 0; g4 < 4; ++g4) {
        { const u32x2 gw = gwv[g4][0]; const f32x4 gv = *(const f32x4*)(gn + 8 * g4);
          O0[4 * g4] = (O0[4 * g4] - mu) * rstd * gv.x * bflo(gw.x); O0[4 * g4 + 1] = (O0[4 * g4 + 1] - mu) * rstd * gv.y * bfhi(gw.x);
          O0[4 * g4 + 2] = (O0[4 * g4 + 2] - mu) * rstd * gv.z * bflo(gw.y); O0[4 * g4 + 3] = (O0[4 * g4 + 3] - mu) * rstd * gv.w * bfhi(gw.y); }
        { const u32x2 gw = gwv[g4][1]; const f32x4 gv = *(const f32x4*)(gn + 32 + 8 * g4);
          O1[4 * g4] = (O1[4 * g4] - mu) * rstd * gv.x * bflo(gw.x); O1[4 * g4 + 1] = (O1[4 * g4 + 1] - mu) * rstd * gv.y * bfhi(gw.x);
          O1[4 * g4 + 2] = (O1[4 * g4 + 2] - mu) * rstd * gv.z * bflo(gw.y); O1[4 * g4 + 3] = (O1[4 * g4 + 3] - mu) * rstd * gv.w * bfhi(gw.y); }
    }
    LAS float* xp = X + iloc * 68 + 4 * hh;
    if (dir == 1) {
#pragma unroll
        for (int g4 = 0; g4 < 4; ++g4) { *(LAS f32x4*)(xp + 8 * g4) = (f32x4){O0[4 * g4], O0[4 * g4 + 1], O0[4 * g4 + 2], O0[4 * g4 + 3]};
            *(LAS f32x4*)(xp + 32 + 8 * g4) = (f32x4){O1[4 * g4], O1[4 * g4 + 1], O1[4 * g4 + 2], O1[4 * g4 + 3]}; }
    }
    __syncthreads();
    if (dir == 0) {
        bf16* yp = Y + (size_t)(row0 + iloc) * D + 512 + hd * 64 + 4 * hh;
#pragma unroll
        for (int g4 = 0; g4 < 4; ++g4) { const f32x4 x0 = *(const LAS f32x4*)(xp + 8 * g4), x1 = *(const LAS f32x4*)(xp + 32 + 8 * g4);
            *(u32x2*)(yp + 8 * g4) = (u32x2){pk2(O0[4 * g4] + x0.x, O0[4 * g4 + 1] + x0.y), pk2(O0[4 * g4 + 2] + x0.z, O0[4 * g4 + 3] + x0.w)};
            *(u32x2*)(yp + 32 + 8 * g4) = (u32x2){pk2(O1[4 * g4] + x1.x, O1[4 * g4 + 1] + x1.y), pk2(O1[4 * g4 + 2] + x1.z, O1[4 * g4 + 3] + x1.w)}; }
    }
    __syncthreads();
}
#define XB_TMO      128
#define XB_XCNT(j)  (256  + 64 * (j))
#define XB_XSUB(j)  (1280 + 64 * (j))
#define XB_XGEN(j)  (2304 + 64 * (j))
#define XB_TOP      3328
#define XB_TOPGEN   3392
#define XCD_BAR_WORDS 3456
#define XB_SPIN_CAP (1u << 18)

__device__ __forceinline__ unsigned xb_ld(unsigned* p)              { return __hip_atomic_load(p, __ATOMIC_RELAXED, __HIP_MEMORY_SCOPE_AGENT); }
__device__ __forceinline__ unsigned xb_add(unsigned* p, unsigned v) { return __hip_atomic_fetch_add(p, v, __ATOMIC_RELAXED, __HIP_MEMORY_SCOPE_AGENT); }
__device__ __forceinline__ unsigned xb_xcc_id() { return (unsigned)__builtin_amdgcn_s_getreg((3 << 11) | 20) & 0xFu; }
#define XB_SPIN(cond, bar) do { unsigned _sp = 0; while (cond) { __builtin_amdgcn_s_sleep(1); \
    if ((++_sp & 255u) == 0u) { if (xb_ld(&(bar)[XB_TMO])) break; if (_sp > XB_SPIN_CAP) { atomicAdd(&(bar)[XB_TMO], 1u); break; } } } } while (0)

struct XcdBarrier {
    unsigned* bar; unsigned x;
    volatile LAS unsigned* st;
};

__device__ __forceinline__ XcdBarrier xcd_barrier_post(unsigned* bar, volatile LAS unsigned* st) {
    XcdBarrier b; b.bar = bar; b.x = xb_xcc_id(); b.st = st;
    if (threadIdx.x == 0) (void)xb_add(&bar[XB_XCNT(b.x)], 1u);
    return b;
}
__device__ __forceinline__ void xcd_barrier_complete(unsigned* bar, unsigned x, unsigned& nloc, unsigned& nx) {
    const unsigned G = gridDim.x * gridDim.y * gridDim.z;
    unsigned sum, cnt, mine, sp = 0u;
    for (;;) {
        sum = 0u; cnt = 0u; mine = 0u;
#pragma unroll
        for (unsigned j = 0; j < 16; ++j) { const unsigned c = xb_ld(&bar[XB_XCNT(j)]); sum += c; cnt += (c > 0u) ? 1u : 0u; mine = (j == x) ? c : mine; }
        if (sum == G) break;
        __builtin_amdgcn_s_sleep(1);
        if ((++sp & 255u) == 0u) { if (xb_ld(&bar[XB_TMO])) break; if (sp > XB_SPIN_CAP) { atomicAdd(&bar[XB_TMO], 1u); break; } }
    }
    nloc = mine > 0u ? mine : 1u; nx = cnt > 0u ? cnt : 1u;
}

__device__ __forceinline__ void xcd_barrier(const XcdBarrier& b) {
    asm volatile("s_waitcnt vmcnt(0)" ::: "memory");
    __syncthreads();
    if (threadIdx.x == 0) {
        unsigned* bar = b.bar;
        __builtin_amdgcn_s_waitcnt(0);
        unsigned nloc = b.st[0], nx = b.st[1];
        if (nloc == 0u) { xcd_barrier_complete(bar, b.x, nloc, nx); b.st[0] = nloc; b.st[1] = nx; }
        const unsigned old = xb_add(&bar[XB_XSUB(b.x)], 1u);
        const unsigned gen = old / nloc;
        if (old + 1u == (gen + 1u) * nloc) {
            __builtin_amdgcn_fence(__ATOMIC_RELEASE, "agent");
            asm volatile("s_waitcnt vmcnt(0)" ::: "memory");
            const unsigned og = xb_add(&bar[XB_TOP], 1u);
            const unsigned tg = og / nx;
            if (og + 1u == (tg + 1u) * nx) xb_add(&bar[XB_TOPGEN], 1u);
            else XB_SPIN(xb_ld(&bar[XB_TOPGEN]) == tg, bar);
            __builtin_amdgcn_fence(__ATOMIC_ACQUIRE, "agent");
            xb_add(&bar[XB_XGEN(b.x)], 1u);
            asm volatile("s_waitcnt vmcnt(0)" ::: "memory");
        } else {
            XB_SPIN(xb_ld(&bar[XB_XGEN(b.x)]) == gen, bar);
            __builtin_amdgcn_fence(__ATOMIC_ACQUIRE, "agent");
            asm volatile("s_waitcnt vmcnt(0)" ::: "memory");
        }
    }
    __syncthreads();
}

#ifndef USE_XCD_BAR
#define USE_XCD_BAR 1
#endif
#ifndef REPEAT_FF1
#define REPEAT_FF1 1
#endif
#ifndef REPEAT_G3
#define REPEAT_G3 1
#endif
#ifndef REPEAT_MIX
#define REPEAT_MIX 1
#endif
#ifndef PHMASK
#define PHMASK 0x1ff
#endif
constexpr int NSTEPS = 2 + 7 * DEPTH;
__global__ void __launch_bounds__(512, 2) mega_fwd(Args a_) {
    extern __shared__ __attribute__((aligned(16))) unsigned char lds_raw[];
    LAS unsigned char* lds = (LAS unsigned char*)lds_raw;
    cg::grid_group grid = cg::this_grid();
    const int step_lo = a_.lo, step_hi = a_.hi;
    volatile LAS unsigned* MISC = (volatile LAS unsigned*)(lds + LDS_ITEM + 64);
    if (threadIdx.x < 2) MISC[threadIdx.x] = 0u;
    __syncthreads();
    for (int step = step_lo; step < step_hi; ++step) {
        if (step > step_lo) {
#if USE_XCD_BAR
            unsigned* barw = (unsigned*)(a_.ws + WS_CTL) + 8192;
            if (step == step_lo + 1) { grid.sync(); (void)xcd_barrier_post(barw, MISC); }
            else { XcdBarrier xb; xb.bar = barw; xb.x = xb_xcc_id(); xb.st = MISC; xcd_barrier(xb); }
#else
            grid.sync();
#endif
        }
        const AS4 Args* ap = (const AS4 Args*)__builtin_amdgcn_kernarg_segment_ptr();
        asm volatile("" : "+s"(ap));
        Args a;
#pragma unroll
        for (int i = 0; i < 18; ++i) a.in[i] = ap->in[i];
        a.out = ap->out; a.ws = ap->ws; a.lo = step_lo; a.hi = step_hi;
        unsigned char* ws = a.ws;
        int G_ = gridDim.x, bid_ = blockIdx.x; asm volatile("" : "+s"(G_), "+s"(bid_));
        const int tid = tid_opaque(), G = G_, bid = bid_;
        bf16* Abuf = (bf16*)(ws + WS_A); bf16* Pbuf = (bf16*)(ws + WS_P); bf16* Hbuf = (bf16*)(ws + WS_H);
        bf16* TTl = (bf16*)(ws + WS_TTL); bf16* TTc = (bf16*)(ws + WS_TTC); float* KV = (float*)(ws + WS_KV);
        float* xc = (float*)(ws + WS_XC);
        if (step == 0) { if (PHMASK & 256) p0_prep(a, lds); continue; }
        if (step == 1) { if (PHMASK & 256) p0b_prep(a, lds); continue; }
        const int l = (step - 2) / 7; int ph = (step - 2) % 7;
        bf16* SSbuf = (bf16*)(ws + WS_TTL);
        if (ph == 2) {
            if ((PHMASK >> 1) & 1) for (int it = bid; it < NB * 4 * 2 * 2; it += G) ret_scan_item(KV, SSbuf, a.in[13] + l * 8, it);
            continue;
        }
        if (ph > 2) --ph;
        const bool last = (l == DEPTH - 1);
        bf16* Ybuf = (bf16*)(ws + WS_Y);
        const int rows = last ? NLAT : M;
        if (!((PHMASK >> ph) & 1)) continue;
        if (ph == 0) {
            pg8::Gemm g{Abuf, (const bf16*)(ws + WS_WIN) + (size_t)l * NIN * D, M, NIN, D}; pg8::StaticOrder S; S.init(M, NIN, G, bid); S.rev = (l > 0) ? 1 : 0;
            EpiWin E{ws, ap, l};
            for (int rep = 0; rep < REPEAT_G3; ++rep)
            pg8::gemm_phase<EpiWin, pg8::StaticOrder, true, true>(lds, g, S, E);
        } else if (ph == 1) {
            for (int rep = 0; rep < REPEAT_MIX; ++rep) {
            unsigned* ctr = (unsigned*)(ws + WS_CTL) + 64 * l + 1024 * rep;
            const int n0 = 128, n1 = n0 + 1024, n2 = n1 + (last ? 0 : 16), n3 = n2 + (last ? 0 : 128), n4 = n3 + NB * 4 * NCH / 4;
            volatile LAS int* slot = (volatile LAS int*)(lds + LDS_ITEM);
            int nextit = 0; if (tid == 0) nextit = (int)atomicAdd(ctr, 1u);
            for (;;) {
                __syncthreads();
                if (tid == 0) *slot = nextit;
                __syncthreads();
                const int it = *slot;
                if (it >= n4) break;
                if (tid == 0) nextit = (int)atomicAdd(ctr, 1u);
                if (it < n0) {
                    pg8::Gemm g{(const bf16*)(ws + WS_DFTL), TTl, 2048, 256, 4096}; OneUnit S; S.u.pm = it & 7; S.u.pn = it >> 3;
                    EpiB16<0, true, false> E{ws, WS_Y, D, SEQ, 0, 768, 0};
                    pg8::gemm_phase<EpiB16<0, true, false>, OneUnit, false, true>(lds, g, S, E);
                } else if (it < n1) {
                    attn_item(lds, Pbuf, Ybuf, a.in[12] + l * 8, it - n0, false);
                } else if (it < n2) {
                    pg8::Gemm g{(const bf16*)(ws + WS_DFTC), TTc, 256, 256, 512}; OneUnit S; S.u.pm = 0; S.u.pn = it - n1;
                    EpiB16<0, true, false> E{ws, WS_Y, D, LCTX, NLAT, 768, 0};
                    pg8::gemm_phase<EpiB16<0, true, false>, OneUnit, false, true>(lds, g, S, E);
                } else if (it < n3) {
                    attn_item(lds, Pbuf, Ybuf, a.in[12] + l * 8, it - n2, true);
                } else {
                    const int i0 = (it - n3) * 4;
                    RsPre cur{}; ret_state_fetch(cur, Pbuf, i0, tid);
#pragma unroll 1
                    for (int s4 = 0; s4 < 4; ++s4) { RsPre nxt = cur; if (s4 < 3) ret_state_fetch(nxt, Pbuf, i0 + s4 + 1, tid);
                        ret_state_item(lds, cur, KV, a.in[13] + l * 8, i0 + s4); cur = nxt; }
                }
            }
            }
        } else if (ph == 2) {
            for (int rep = 0; rep < REPEAT_MIX; ++rep) {
                const int NIT = NB * 4 * NCH;
                int it = bid; while (it < NIT && last && (it % NCH) < 2) it += G;
                RetPre cur{}; if (it < NIT) ret_out_fetch(cur, Pbuf, SSbuf, it, tid);
                while (it < NIT) {
                    int nx = it + G; while (nx < NIT && last && (nx % NCH) < 2) nx += G;
                    RetPre nxt = cur; if (nx < NIT) ret_out_fetch(nxt, Pbuf, SSbuf, nx, tid);
                    ret_out_item(lds, Pbuf, cur, Ybuf, a.in[13] + l * 8, a.in[14] + l * 256, it);
                    cur = nxt; it = nx;
                }
            }
        } else if (ph == 3) {
            pg8::Gemm g{Ybuf, (const bf16*)(ws + WS_WOUT) + (size_t)l * D * D, rows, D, D}; pg8::StaticOrder S; S.init(rows, D, G, bid);
            EpiRes<true> E{ws, ap, l, 0};
            if (REPEAT_G3 > 1) { EpiB16<0, false, false> E2{ws, WS_P, D, 0, 0, 0, 0}; pg8::gemm_phase<EpiB16<0, false, false>, pg8::StaticOrder, true, true>(lds, g, S, E2); }
            pg8::gemm_phase<EpiRes<true>, pg8::StaticOrder, true, true>(lds, g, S, E);
            if (!last) {
                const int first = ((rows / 256) * (D / 256)) % G;
                if (bid >= first) p0_weights(a, lds, l + 1, l + 2, bid - first, G - first);
            }
        } else if (ph == 4) {
            pg8::Gemm g{Abuf, (const bf16*)(ws + WS_W1) + (size_t)l * FF * D, rows, FF, D}; pg8::StaticOrder S; S.init(rows, FF, G, bid); S.rev = 1;
            EpiB16<1, false, true> E{ws, WS_H, FF, 0, 0, 0, l};
            for (int rep = 0; rep < REPEAT_FF1; ++rep)
            pg8::gemm_phase<EpiB16<1, false, true>, pg8::StaticOrder, true, true>(lds, g, S, E);
        } else {
            pg8::Gemm g{Hbuf, (const bf16*)(ws + WS_W2) + (size_t)l * D * FF, rows, D, FF}; pg8::StaticOrder S; S.init(rows, D, G, bid);
            if (REPEAT_G3 > 1) { EpiB16<0, false, false> E2{ws, WS_A, D, 0, 0, 0, 0}; pg8::gemm_phase<EpiB16<0, false, false>, pg8::StaticOrder, true, true>(lds, g, S, E2); }
            if (!last) { EpiRes<true> E{ws, ap, l, 1};
                pg8::gemm_phase<EpiRes<true>, pg8::StaticOrder, true, true>(lds, g, S, E);
                const int first = ((rows / 256) * (D / 256)) % G;
                if (bid >= first) p0_bias(a, lds, l + 1, l + 2, bid - first, G - first); }
            else { EpiRes<false> E{ws, ap, l, 1};
                pg8::gemm_phase<EpiRes<false>, pg8::StaticOrder, true, true>(lds, g, S, E); }
        }
    }
}
}

extern "C" void kernel_launch(void* const* d_in, const int* in_sizes, int n_in, void* d_out, int out_size, void* d_ws, size_t ws_size, hipStream_t stream) {
    using namespace mk;
    static int grid = 0;
    if (grid == 0) {
        if (n_in != 18 || in_sizes[0] != NLAT * D || out_size != NLAT * D || ws_size < WS_END) { fprintf(stderr, "kernel_launch: unexpected shapes (n_in %d, out %d, ws %zu)\n", n_in, out_size, ws_size); grid = -1; return; }
        int dev = 0, cus = 0, per_cu = 0;
        (void)hipGetDevice(&dev);
        (void)hipDeviceGetAttribute(&cus, hipDeviceAttributeMultiprocessorCount, dev);
        if (hipFuncSetAttribute((const void*)mega_fwd, hipFuncAttributeMaxDynamicSharedMemorySize, LDS_BYTES) != hipSuccess) { fprintf(stderr, "kernel_launch: hipFuncSetAttribute failed\n"); grid = -1; return; }
        if (hipOccupancyMaxActiveBlocksPerMultiprocessor(&per_cu, (const void*)mega_fwd, 512, LDS_BYTES) != hipSuccess || per_cu < 1) { fprintf(stderr, "kernel_launch: occupancy query gave %d\n", per_cu); per_cu = 1; }
        (void)hipGetLastError();
        grid = cus * per_cu;
    }
    if (grid < 0) return;
    Args a{};
    for (int i = 0; i < 18; ++i) a.in[i] = (const float*)d_in[i];
    a.out = (float*)d_out; a.ws = (unsigned char*)d_ws;
#if ONE_LAUNCH
    a.lo = 0; a.hi = NSTEPS;
    void* args[] = {&a};
    hipError_t e = hipLaunchCooperativeKernel((const void*)mega_fwd, dim3(grid), dim3(512), args, LDS_BYTES, stream);
    if (e != hipSuccess) fprintf(stderr, "cooperative launch failed: %s (grid %d)\n", hipGetErrorString(e), grid);
#else
    for (int s = 0; s < NSTEPS; ++s) { a.lo = s; a.hi = s + 1; hipLaunchKernelGGL(mega_fwd, dim3(grid), dim3(512), LDS_BYTES, stream, a); }
#endif
}
```
